# Optimizing an MI355X kernel written in HIP

```python
import jax, jax.numpy as jnp
from jax import lax
import numpy as np

D_MODEL = 1024
BATCH = 8
SEQ = 4096
DEPTH = 4

N_META = 16
D_ATTN = D_MODEL // 2
D_RNN = D_MODEL - D_ATTN
N_HEADS = 8
QK_NOPE = 64
QK_ROPE = 32
QK_HEAD = QK_NOPE + QK_ROPE
V_HEAD = D_ATTN // N_HEADS
Q_LORA = 384
KV_LORA = 256
ROPE_BASE = 10000.0
N_RNN_BLOCKS = 8
RNN_BLOCK = D_RNN // N_RNN_BLOCKS
CONV_W = 4
LRU_C = 8.0
D_FF = 2816
N_EXPERTS = 8
TOP_K = 2
D_FF_EXPERT = 1408
Q_BLOCK = 128
EPS = 1e-6
N_DENSE = (DEPTH + 1) // 2
N_MOE = DEPTH // 2
SPLITS = (Q_LORA, Q_LORA + KV_LORA, Q_LORA + KV_LORA + QK_ROPE, Q_LORA + KV_LORA + QK_ROPE + D_RNN)
D_IN = Q_LORA + KV_LORA + QK_ROPE + 2 * D_RNN

kernel_name = "hymba_mla_rglru_moe_trunk"


def rmsnorm(x, g):
    xf = x.astype(jnp.float32)
    y = xf * lax.rsqrt(jnp.mean(xf * xf, axis=-1, keepdims=True) + EPS)
    return (y * g.astype(jnp.float32)).astype(x.dtype)


def rope_tables(pos):
    inv_freq = ROPE_BASE ** (-jnp.arange(0, QK_ROPE, 2, dtype=jnp.float32) / QK_ROPE)
    ang = pos.astype(jnp.float32)[..., None] * inv_freq
    return jnp.cos(ang), jnp.sin(ang)


def apply_rope(x, cos, sin):
    xf = x.astype(jnp.float32)
    x1, x2 = xf[..., : QK_ROPE // 2], xf[..., QK_ROPE // 2:]
    c, s = cos[:, :, None, :], sin[:, :, None, :]
    return jnp.concatenate([x1 * c - x2 * s, x2 * c + x1 * s], axis=-1).astype(x.dtype)


def causal_block_attention(q, k, v):
    T = q.shape[1]
    bounds = sorted(set([0, N_META] + list(range(N_META + Q_BLOCK, T, Q_BLOCK)) + [T]))
    scale = QK_HEAD ** -0.5
    outs = []
    for s, e in zip(bounds[:-1], bounds[1:]):
        sc = jnp.einsum('bqhd,bkhd->bhqk', q[:, s:e], k[:, :e]).astype(jnp.float32) * scale
        mask = jnp.arange(e)[None, :] <= jnp.arange(s, e)[:, None]
        p = jax.nn.softmax(jnp.where(mask, sc, -1e30), axis=-1)
        outs.append(jnp.einsum('bhqk,bkhd->bqhd', p.astype(v.dtype), v[:, :e]))
    return jnp.concatenate(outs, axis=1)


def mla_mixer(cq, ckv, kr, cos, sin, q_norm_g, w_uq, kv_norm_g, w_ukv, q_head_g, k_head_g):
    B, T, _ = cq.shape
    q = (rmsnorm(cq, q_norm_g) @ w_uq).reshape(B, T, N_HEADS, QK_HEAD)
    kv = (rmsnorm(ckv, kv_norm_g) @ w_ukv).reshape(B, T, N_HEADS, QK_NOPE + V_HEAD)
    k_nope, v = kv[..., :QK_NOPE], kv[..., QK_NOPE:]
    k = jnp.concatenate([k_nope, jnp.broadcast_to(kr[:, :, None, :], (B, T, N_HEADS, QK_ROPE))], axis=-1)
    q = rmsnorm(q, q_head_g)
    k = rmsnorm(k, k_head_g)
    q = jnp.concatenate([q[..., :QK_NOPE], apply_rope(q[..., QK_NOPE:], cos, sin)], axis=-1)
    k = jnp.concatenate([k[..., :QK_NOPE], apply_rope(k[..., QK_NOPE:], cos, sin)], axis=-1)
    o = causal_block_attention(q, k, v)
    return o.reshape(B, T, D_ATTN)


def _lin_combine(left, right):
    a_l, b_l = left
    a_r, b_r = right
    return a_l * a_r, a_r * b_l + b_r


def rglru_mixer(xr, gate, conv_w, conv_b, w_a, b_a, w_i, b_i, lam):
    B, T, _ = xr.shape
    xp = jnp.pad(xr, ((0, 0), (CONV_W - 1, 0), (0, 0)))
    xc = conv_b + xp[:, 0:T] * conv_w[0]
    for j in range(1, CONV_W):
        xc = xc + xp[:, j:j + T] * conv_w[j]
    xb = xc.reshape(B, T, N_RNN_BLOCKS, RNN_BLOCK)
    r = jax.nn.sigmoid(jnp.einsum('btnc,ncd->btnd', xb, w_a).reshape(B, T, D_RNN) + b_a)
    i = jax.nn.sigmoid(jnp.einsum('btnc,ncd->btnd', xb, w_i).reshape(B, T, D_RNN) + b_i)
    log_a = -LRU_C * r.astype(jnp.float32) * jax.nn.softplus(-lam.astype(jnp.float32))
    a = jnp.exp(log_a)
    mult = jnp.sqrt(-jnp.expm1(2.0 * log_a))
    b = mult * i.astype(jnp.float32) * xc.astype(jnp.float32)
    _, h = lax.associative_scan(_lin_combine, (a, b), axis=1)
    return h.astype(xr.dtype) * jax.nn.gelu(gate, approximate=True)


def swiglu(x, w_g, w_u, w_d):
    return (jax.nn.silu(x @ w_g) * (x @ w_u)) @ w_d


def moe_swiglu(x, w_router, w_g, w_u, w_d):
    B, T, D = x.shape
    xt = x.reshape(-1, D)
    logits = (xt @ w_router).astype(jnp.float32)
    top_val, top_idx = lax.top_k(logits, TOP_K)
    top_w = jax.nn.softmax(top_val, axis=-1)
    gates = jnp.sum(jax.nn.one_hot(top_idx, N_EXPERTS, dtype=jnp.float32) * top_w[..., None], axis=1)
    gates = gates.astype(x.dtype)
    out = jnp.zeros_like(xt)
    for e in range(N_EXPERTS):
        h = jax.nn.silu(xt @ w_g[e]) * (xt @ w_u[e])
        out = out + (gates[:, e:e + 1] * h) @ w_d[e]
    return out.reshape(B, T, D)


def setup_inputs(seed: int = 0) -> dict:
    key = jax.random.key(seed)
    ks = iter(jax.random.split(key, 40))

    def nrm(shape, fan_in):
        return jax.random.normal(next(ks), shape, jnp.float32) * (fan_in ** -0.5)

    def gain(shape):
        return 1.0 + 0.02 * jax.random.normal(next(ks), shape, jnp.float32)

    def bias(shape):
        return 0.02 * jax.random.normal(next(ks), shape, jnp.float32)

    x = jax.random.normal(next(ks), (BATCH, SEQ, D_MODEL), jnp.float32)
    start = jax.random.randint(next(ks), (BATCH, 1), 0, 1024, dtype=jnp.int32)
    positions = (start + jnp.arange(SEQ, dtype=jnp.int32)[None, :]).astype(jnp.int32)
    meta_tokens = jax.random.normal(next(ks), (N_META, D_MODEL), jnp.float32)
    u = jax.random.uniform(next(ks), (DEPTH, D_RNN), jnp.float32, 0.9, 0.999)
    s = u ** (1.0 / LRU_C)
    lru_lambda = jnp.log(s) - jnp.log1p(-s)
    return {
        "x": x,
        "positions": positions,
        "meta_tokens": meta_tokens,
        "norm_mix_g": gain((DEPTH, D_MODEL)),
        "w_in": nrm((DEPTH, D_MODEL, D_IN), D_MODEL),
        "q_norm_g": gain((DEPTH, Q_LORA)),
        "w_uq": nrm((DEPTH, Q_LORA, N_HEADS * QK_HEAD), Q_LORA),
        "kv_norm_g": gain((DEPTH, KV_LORA)),
        "w_ukv": nrm((DEPTH, KV_LORA, N_HEADS * (QK_NOPE + V_HEAD)), KV_LORA),
        "q_head_g": gain((DEPTH, QK_HEAD)),
        "k_head_g": gain((DEPTH, QK_HEAD)),
        "conv_w": nrm((DEPTH, CONV_W, D_RNN), CONV_W),
        "conv_b": bias((DEPTH, D_RNN)),
        "w_a": nrm((DEPTH, N_RNN_BLOCKS, RNN_BLOCK, RNN_BLOCK), RNN_BLOCK),
        "b_a": bias((DEPTH, D_RNN)),
        "w_i": nrm((DEPTH, N_RNN_BLOCKS, RNN_BLOCK, RNN_BLOCK), RNN_BLOCK),
        "b_i": bias((DEPTH, D_RNN)),
        "lru_lambda": lru_lambda,
        "attn_out_g": gain((DEPTH, D_ATTN)),
        "rnn_out_g": gain((DEPTH, D_RNN)),
        "w_out": nrm((DEPTH, D_MODEL, D_MODEL), D_MODEL),
        "norm_ffn_g": gain((DEPTH, D_MODEL)),
        "ffn_w_gate": nrm((N_DENSE, D_MODEL, D_FF), D_MODEL),
        "ffn_w_up": nrm((N_DENSE, D_MODEL, D_FF), D_MODEL),
        "ffn_w_down": nrm((N_DENSE, D_FF, D_MODEL), D_FF),
        "router_w": nrm((N_MOE, D_MODEL, N_EXPERTS), D_MODEL),
        "moe_w_gate": nrm((N_MOE, N_EXPERTS, D_MODEL, D_FF_EXPERT), D_MODEL),
        "moe_w_up": nrm((N_MOE, N_EXPERTS, D_MODEL, D_FF_EXPERT), D_MODEL),
        "moe_w_down": nrm((N_MOE, N_EXPERTS, D_FF_EXPERT, D_MODEL), D_FF_EXPERT),
    }


def reference(x, positions, meta_tokens, norm_mix_g, w_in, q_norm_g, w_uq, kv_norm_g, w_ukv,
              q_head_g, k_head_g, conv_w, conv_b, w_a, b_a, w_i, b_i, lru_lambda,
              attn_out_g, rnn_out_g, w_out, norm_ffn_g, ffn_w_gate, ffn_w_up, ffn_w_down,
              router_w, moe_w_gate, moe_w_up, moe_w_down):
    B = x.shape[0]
    meta = jnp.broadcast_to(meta_tokens[None].astype(x.dtype), (B, N_META, D_MODEL))
    h = jnp.concatenate([meta, x], axis=1)
    meta_pos = jnp.broadcast_to(jnp.arange(N_META, dtype=jnp.int32)[None, :], (B, N_META))
    pos_full = jnp.concatenate([meta_pos, positions.astype(jnp.int32) + N_META], axis=1)
    cos, sin = rope_tables(pos_full)
    for l in range(DEPTH):
        u = rmsnorm(h, norm_mix_g[l])
        proj = u @ w_in[l]
        cq, ckv, kr, xr, gt = jnp.split(proj, SPLITS, axis=-1)
        att = mla_mixer(cq, ckv, kr, cos, sin, q_norm_g[l], w_uq[l], kv_norm_g[l], w_ukv[l],
                        q_head_g[l], k_head_g[l])
        rnn = rglru_mixer(xr, gt, conv_w[l], conv_b[l], w_a[l], b_a[l], w_i[l], b_i[l], lru_lambda[l])
        mix = jnp.concatenate([rmsnorm(att, attn_out_g[l]), rmsnorm(rnn, rnn_out_g[l])], axis=-1)
        h = h + mix @ w_out[l]
        u = rmsnorm(h, norm_ffn_g[l])
        if l % 2 == 0:
            j = l // 2
            h = h + swiglu(u, ffn_w_gate[j], ffn_w_up[j], ffn_w_down[j])
        else:
            j = l // 2
            h = h + moe_swiglu(u, router_w[j], moe_w_gate[j], moe_w_up[j], moe_w_down[j])
    return h[:, N_META:]
```

```cpp
#include <hip/hip_runtime.h>
#include <cstdio>
#include <cstdint>
#include <type_traits>

#define LAS __attribute__((address_space(3)))
#define GAS __attribute__((address_space(1)))
typedef unsigned short bf16_t;
typedef short bf16x8 __attribute__((ext_vector_type(8)));
typedef float f32x4 __attribute__((ext_vector_type(4)));
typedef float f32x2 __attribute__((ext_vector_type(2)));
typedef unsigned u32x4 __attribute__((ext_vector_type(4)));
typedef unsigned u32x2 __attribute__((ext_vector_type(2)));
typedef GAS unsigned gu32;

constexpr int NB = 8, SEQ = 4096, NMETA = 16, DM = 1024, DEPTH = 4;
constexpr int MR = NB * SEQ;
constexpr int MP = MR + 256;
constexpr int NPANEL = MP / 256;
constexpr int MVALID = MR + NMETA;
constexpr int QL = 384, KVL = 256, ROPE = 32, DR = 512, DIN = 1696;
constexpr int NH = 8, QKN = 64, QKH = 96, VH = 64;
constexpr int DFF = 2816, NE = 8, DFE = 1408;
constexpr int NPROJ = 1792;
constexpr float EPS = 1e-6f;
constexpr int NWAVES = 8, NTHREADS = 512;
constexpr int SCAN_CH = 128, SCAN_NCH = SEQ / SCAN_CH;

constexpr size_t MiB = 1u << 20, QMiB = 1u << 18;
constexpr size_t WS_CTL = 0, CTL_ZERO_BYTES = 1 * MiB;
constexpr size_t WS_ROPE = 4 * QMiB;
constexpr size_t WS_LIST = 21 * QMiB;
constexpr size_t WS_WLIST = 30 * QMiB;
constexpr size_t WS_SCAN = 47 * QMiB;
constexpr size_t WS_SSQ1 = 51 * QMiB;
constexpr size_t WS_SSQ2 = 60 * QMiB;
constexpr size_t WS_SSQC = 69 * QMiB;
constexpr size_t WS_W = 20 * MiB;
constexpr size_t WS_BUFA = 148 * MiB;
constexpr size_t WS_T = 213 * MiB;
constexpr size_t WS_HB = 400 * MiB;
constexpr size_t WS_W8 = 465 * MiB;
constexpr size_t SZ_W8 = (size_t)2 * DFF * DM;
constexpr size_t WS_HB8 = 476 * MiB;
constexpr size_t WS_END = 509 * MiB;
static_assert(WS_W8 + 2 * SZ_W8 <= WS_HB8 && WS_HB8 + (size_t)MP * DM <= WS_END, "fp8 buffers");
constexpr size_t SZ512 = (size_t)MP * 512 * 2;
static_assert(WS_ROPE + (size_t)MP * 32 * 4 <= WS_LIST && WS_LIST + (size_t)16 * MP * 4 <= WS_WLIST && WS_WLIST + (size_t)16 * MP * 8 <= WS_SCAN && WS_SCAN + MiB <= WS_SSQ1 && WS_SSQ1 + (size_t)MP * 64 <= WS_SSQ2 && WS_SSQ2 + (size_t)MP * 64 <= WS_SSQC && WS_SSQC + (size_t)MP * 64 <= WS_W, "small tables");
constexpr size_t T_CQ = WS_T, T_CKV = T_CQ + SZ512, T_XR = T_CKV + SZ512 / 2, T_XC = T_XR + SZ512, T_GT = T_XC + SZ512, T_RNN = T_GT + SZ512, T_ENDMIX = T_RNN + SZ512;
constexpr size_t T_K = WS_BUFA;
constexpr size_t T_V = T_XR;
constexpr size_t T_ATT = T_CQ;
constexpr size_t T_ACT = WS_T;
static_assert(T_ENDMIX <= WS_HB, "mixer temporaries fit");
static_assert(T_ACT + (size_t)272 * 256 * DFE * 2 <= WS_HB && T_ACT + (size_t)MP * DFF * 2 <= WS_HB && WS_HB + (size_t)MP * DM * 2 <= WS_END, "FFN activations + residual fit");
constexpr size_t D_Q = 0, D_AB = (size_t)MP * 768 * 2;
static_assert(D_AB + (size_t)MP * 512 * 4 <= (size_t)MR * DM * 4, "d_out scratch");
constexpr size_t W_IN = 0, SZ_IN = (size_t)NPROJ * DM * 2;
constexpr size_t W_UQ = W_IN + SZ_IN, SZ_UQ = (size_t)768 * QL * 2;
constexpr size_t W_UKV = W_UQ + SZ_UQ, SZ_UKV = (size_t)1024 * KVL * 2;
constexpr size_t W_G = W_UKV + SZ_UKV, SZ_G = (size_t)1024 * 256 * 2;
constexpr size_t W_OUT = W_G + SZ_G, SZ_OUT = (size_t)DM * DM * 2;
constexpr size_t W_LAYER = W_OUT + SZ_OUT;
constexpr size_t W_DENSE = 4 * W_LAYER, SZ_UP = (size_t)2 * DFF * DM * 2, SZ_DN = (size_t)DM * DFF * 2, W_DENSE_STRIDE = SZ_UP + SZ_DN;
constexpr size_t W_MOE = W_DENSE + 2 * W_DENSE_STRIDE, SZ_MUP = (size_t)2 * DFE * DM * 2, SZ_MDN = (size_t)DM * DFE * 2;
constexpr int DFE8 = 1536;
constexpr size_t SZ_MDN8 = (size_t)DM * DFE8;
constexpr size_t SZ_MUP8 = (size_t)2 * DFE * DM;
constexpr size_t SZ_DN8 = (size_t)DM * DFF;
constexpr size_t W_MOE_DN = W_MOE + NE * SZ_MUP, W_END = W_MOE_DN + NE * SZ_MDN;
static_assert(WS_W + W_END <= WS_BUFA, "weights fit");
static_assert(NE * SZ_MUP8 + 2 * SZ_DN8 <= NE * SZ_MUP, "fp8 expert up weights + fp8 dense down weights share the (bf16-sized) MoE up-weight region");
constexpr int CW_TMO = 0, CW_BAR = 4096, CW_MOE = 16384;

constexpr int RING_BYTES = 131072, LDSCTL_OFF = RING_BYTES, MISC_OFF = LDSCTL_OFF + 320, LDS_BYTES = 147456;

#define RLX_AGENT __ATOMIC_RELAXED, __HIP_MEMORY_SCOPE_AGENT
#define LDS_WAIT() asm volatile("s_waitcnt lgkmcnt(0)" ::: "memory")
#define VM_WAIT() asm volatile("s_waitcnt vmcnt(0)" ::: "memory")
__device__ __forceinline__ unsigned f2bf(float f) { unsigned u = __builtin_bit_cast(unsigned, f); return (u + 0x7fffu + ((u >> 16) & 1u)) >> 16; }
__device__ __forceinline__ unsigned pk2(float lo, float hi) { return f2bf(lo) | (f2bf(hi) << 16); }
__device__ __forceinline__ unsigned pk4_fp8(float a, float b, float c, float d) { int r = __builtin_amdgcn_cvt_pk_fp8_f32(a, b, 0, false); r = __builtin_amdgcn_cvt_pk_fp8_f32(c, d, r, true); return (unsigned)r; }
__device__ __forceinline__ float bflo(unsigned w) { return __builtin_bit_cast(float, w << 16); }
__device__ __forceinline__ float bfhi(unsigned w) { return __builtin_bit_cast(float, w & 0xffff0000u); }
__device__ __forceinline__ float bf2f(bf16_t h) { return __builtin_bit_cast(float, (unsigned)h << 16); }
__device__ __forceinline__ float shfl_xor_(float v, int mask, int lane) {
    const int x = __builtin_bit_cast(int, v);
    if (mask == 1) return __builtin_bit_cast(float, __builtin_amdgcn_update_dpp(0, x, 0xB1, 0xF, 0xF, true));
    if (mask == 2) return __builtin_bit_cast(float, __builtin_amdgcn_update_dpp(0, x, 0x4E, 0xF, 0xF, true));
    if (mask == 4) { int t = __builtin_amdgcn_update_dpp(x, x, 0x104, 0xF, 0x5, false); t = __builtin_amdgcn_update_dpp(t, x, 0x114, 0xF, 0xA, false); return __builtin_bit_cast(float, t); }
    if (mask == 8) return __builtin_bit_cast(float, __builtin_amdgcn_update_dpp(0, x, 0x128, 0xF, 0xF, true));
    if (mask == 16) { const auto r = __builtin_amdgcn_permlane16_swap((unsigned)x, (unsigned)x, false, false); return __builtin_bit_cast(float, (lane & 16) ? r[0] : r[1]); }
    const auto r = __builtin_amdgcn_permlane32_swap((unsigned)x, (unsigned)x, false, false); return __builtin_bit_cast(float, (lane & 32) ? r[0] : r[1]);
}
__device__ __forceinline__ float wave_sum(float v, int lane) {
#pragma unroll
    for (int o = 1; o < 64; o <<= 1) v += shfl_xor_(v, o, lane);
    return v;
}
__device__ __forceinline__ float sigmoidf_(float x) { return __builtin_amdgcn_rcpf(1.0f + __builtin_amdgcn_exp2f(-1.4426950408889634f * x)); }
__device__ __forceinline__ float siluf_(float x) { return x * __builtin_amdgcn_rcpf(1.0f + __builtin_amdgcn_exp2f(-1.4426950408889634f * x)); }
__device__ __forceinline__ float gelu_tanhf_(float x) { const float z = 0.7978845608028654f * (x + 0.044715f * x * x * x); return x * __builtin_amdgcn_rcpf(1.0f + __builtin_amdgcn_exp2f(-2.8853900817779268f * z)); }

__device__ __forceinline__ void glds16(const char* sbase, unsigned voff, unsigned lds_dst) { unsigned keep;
    asm volatile("s_mov_b32 %0, m0\n\ts_mov_b32 m0, %3\n\ts_nop 0\n\tglobal_load_lds_dwordx4 %1, %2\n\ts_mov_b32 m0, %0" : "=&s"(keep) : "v"(voff), "s"(sbase), "s"(lds_dst) : "memory"); }
namespace pg8 {
constexpr int BM = 256, BK = 64, HALF = 128, HTB = HALF * BK * 2, NXCD = 8, WGM = 8;
__host__ __device__ __forceinline__ int lds_byte(int r, int c) { const int st = (r >> 4) * 2 + (c >> 5), rr = r & 15, cc = c & 31, ob = rr * 64 + cc * 2; return st * 1024 + (ob ^ (((ob >> 9) & 1) << 5)); }
__host__ __device__ __forceinline__ void stage_rc(int b, int& R, int& C) { const int st = b / 1024, sb = b % 1024, swz = sb ^ (((sb >> 9) & 1) << 5); R = (st >> 1) * 16 + swz / 64; C = (st & 1) * 32 + (swz % 64) / 2; }
__host__ __device__ __forceinline__ int perm32(int rho) { const int n = rho >> 4, i = rho & 15; return 8 * (i >> 2) + 4 * n + (i & 3); }

struct Unit { int pm, pn; unsigned aoff, boff; int grp, prow; };
struct Gemm { const bf16_t* A; const bf16_t* Bt; int lda, ldb, K; };

struct StaticOrder {
    static constexpr bool THIN_META = true;
    int nM, nN, nwg, G, c;
    __device__ void init(int nM_, int nN_, int G_, int c_) { nM = nM_; nN = nN_; nwg = nM * nN; G = G_; c = c_; }
    __device__ bool next(int i, Unit& u) const {
        const long L = (long)i * G + c; if (L >= nwg) return false;
        int wgid = (int)L; { const int q = nwg / NXCD, r = nwg % NXCD, xcd = wgid % NXCD, off = wgid / NXCD; wgid = (xcd < r ? xcd * (q + 1) : r * (q + 1) + (xcd - r) * q) + off; }
        const int nig = WGM * nN, gid = wgid / nig, fm = gid * WGM, gsz = (nM - fm) < WGM ? (nM - fm) : WGM;
        u.pm = fm + ((wgid % nig) % gsz); u.pn = (wgid % nig) / gsz; u.aoff = 0; u.boff = 0; u.grp = 0; u.prow = 0; return true;
    }
    __device__ __forceinline__ int arow(const Unit&, int) const { return 0; }
};

__device__ __forceinline__ const char* uptr(const char* p) {
    const unsigned long long v = (unsigned long long)p; const unsigned lo = __builtin_amdgcn_readfirstlane((unsigned)v), hi = __builtin_amdgcn_readfirstlane((unsigned)(v >> 32));
    return (const char*)(((unsigned long long)hi << 32) | lo); }
typedef int v8i __attribute__((ext_vector_type(8)));
typedef int v4i __attribute__((ext_vector_type(4)));
__device__ __forceinline__ v8i fp8cat(const bf16x8 a, const bf16x8 b) { return __builtin_shufflevector(__builtin_bit_cast(v4i, a), __builtin_bit_cast(v4i, b), 0, 1, 2, 3, 4, 5, 6, 7); }
__device__ __forceinline__ unsigned cvt_pk_bf16(float lo, float hi) { unsigned r; asm volatile("v_cvt_pk_bf16_f32 %0, %1, %2" : "=v"(r) : "v"(lo), "v"(hi)); return r; }

template <class T, class = void> struct epi_caches_rows : std::false_type {};
template <class T> struct epi_caches_rows<T, std::void_t<decltype(T::CACHE_ROWS)>> : std::true_type {};
template <class Epi, class Sched, bool GATHER = false, bool FP8 = false>
__device__ __forceinline__ void gemm_phase(LAS unsigned char* lds, const Gemm g, const Sched& S, const Epi& E, int tid_) {
    asm volatile("" : "+v"(tid_));
    const int tid = tid_, wid = __builtin_amdgcn_readfirstlane(tid >> 6), lane = tid & 63, wr = wid >> 2, wc = wid & 3, fr = lane & 15, fq = lane >> 4;
    const int K = g.K, nt = K / BK;
    unsigned voffB[2], vC[2][2], vN[2][2]; int sR[2], sC[2];
    const size_t kstep = (size_t)(BK * 2);
    const size_t hstepA = (size_t)HALF * g.lda * 2, tstepA = 2 * hstepA, hstepB = (size_t)HALF * g.ldb * 2, tstepB = 2 * hstepB;
#pragma unroll
    for (int i = 0; i < 2; ++i) { int R, C; stage_rc(tid * 16 + i * 8192, R, C); const int Rb = Epi::PERM ? ((R & ~31) + perm32(R & 31)) : R; sR[i] = R; sC[i] = C;
        voffB[i] = (unsigned)(Rb * g.ldb + C) * 2u;
        if (!GATHER) { vC[0][i] = (unsigned)(R * g.lda + C) * 2u; vC[1][i] = vC[0][i]; vN[0][i] = vC[0][i]; vN[1][i] = vC[0][i]; } }
    const unsigned ldsw = (unsigned)wid * 1024u, lds0 = (unsigned)(uintptr_t)lds;
    const int aoff = lds_byte(wr * 64 + fr, fq * 8), boff = lds_byte(wc * 32 + fr, fq * 8);
#define PG8_SA(b, h) (((b) * 2 + (h)) * HTB)
#define PG8_SB(b, h) ((4 + (b) * 2 + (h)) * HTB)
#define PG8_STAGE(bufoff, gbase, voff) do { const char* _gb = uptr((const char*)(gbase)); const unsigned _ld = (unsigned)__builtin_amdgcn_readfirstlane((int)(lds0 + (bufoff) + ldsw)); \
        glds16(_gb, (voff)[0], _ld); glds16(_gb, (voff)[1], _ld + 8192u); } while (0)
#define PG8_STAGE_A(bufoff, gbase, v0, v1) do { const char* _gb = uptr((const char*)(gbase) + ((!GATHER && ((bufoff) / HTB) % 2 == 1) ? hstepA : 0)); const unsigned _ld = (unsigned)__builtin_amdgcn_readfirstlane((int)(lds0 + (bufoff) + ldsw)); \
        glds16(_gb, (v0), _ld); glds16(_gb, (v1), _ld + 8192u); } while (0)
#define PG8_LDA(dst, b, h) do { if (FP8) { _Pragma("unroll") for (int m = 0; m < 4; ++m) dst##8[m] = fp8cat(*(const LAS bf16x8*)(lds + PG8_SA(b, h) + aoff + m * 2048), *(const LAS bf16x8*)(lds + PG8_SA(b, h) + aoff + m * 2048 + 1024)); } \
        else { _Pragma("unroll") for (int m = 0; m < 4; ++m) _Pragma("unroll") for (int k = 0; k < 2; ++k) dst[m][k] = *(const LAS bf16x8*)(lds + PG8_SA(b, h) + aoff + m * 2048 + k * 1024); } } while (0)
#define PG8_LDB(dst, b, h) do { if (FP8) { _Pragma("unroll") for (int n = 0; n < 2; ++n) dst##8[n] = fp8cat(*(const LAS bf16x8*)(lds + PG8_SB(b, h) + boff + n * 2048), *(const LAS bf16x8*)(lds + PG8_SB(b, h) + boff + n * 2048 + 1024)); } \
        else { _Pragma("unroll") for (int n = 0; n < 2; ++n) _Pragma("unroll") for (int k = 0; k < 2; ++k) dst[n][k] = *(const LAS bf16x8*)(lds + PG8_SB(b, h) + boff + n * 2048 + k * 1024); } } while (0)
#define PG8_MMA(ai, bj, At, Bt, Z) do { __builtin_amdgcn_s_setprio(1); \
        if (Z) {        \
            if (FP8) { _Pragma("unroll") for (int m = 0; m < 4; ++m) _Pragma("unroll") for (int n = 0; n < 2; ++n) \
                asm volatile("v_mfma_scale_f32_16x16x128_f8f6f4 %0, %1, %2, 0, %3, %3 op_sel_hi:[0,0,0]" : "=&v"(acc[ai][bj][m][n]) : "v"(Bt##8[n]), "v"(At##8[m]), "v"(sc8)); } \
            else { _Pragma("unroll") for (int m = 0; m < 4; ++m) _Pragma("unroll") for (int n = 0; n < 2; ++n) { \
                acc[ai][bj][m][n] = __builtin_amdgcn_mfma_f32_16x16x32_bf16(Bt[n][0], At[m][0], (f32x4){0.f, 0.f, 0.f, 0.f}, 0, 0, 0); acc[ai][bj][m][n] = __builtin_amdgcn_mfma_f32_16x16x32_bf16(Bt[n][1], At[m][1], acc[ai][bj][m][n], 0, 0, 0); } } \
        } else if (FP8) { _Pragma("unroll") for (int m = 0; m < 4; ++m) _Pragma("unroll") for (int n = 0; n < 2; ++n) \
            asm volatile("v_mfma_scale_f32_16x16x128_f8f6f4 %0, %1, %2, %0, %3, %3 op_sel_hi:[0,0,0]" : "+v"(acc[ai][bj][m][n]) : "v"(Bt##8[n]), "v"(At##8[m]), "v"(sc8)); } \
        else { _Pragma("unroll") for (int m = 0; m < 4; ++m) _Pragma("unroll") for (int n = 0; n < 2; ++n) _Pragma("unroll") for (int k = 0; k < 2; ++k) \
            acc[ai][bj][m][n] = __builtin_amdgcn_mfma_f32_16x16x32_bf16(Bt[n][k], At[m][k], acc[ai][bj][m][n], 0, 0, 0); } __builtin_amdgcn_s_setprio(0); } while (0)
#define PG8_MMA_THIN(ai, bj, At, Bt, Z) do { if ((ai) == 0 && wr == 0) { _Pragma("unroll") for (int n = 0; n < 2; ++n) _Pragma("unroll") for (int k = 0; k < 2; ++k) \
        acc[0][bj][0][n] = __builtin_amdgcn_mfma_f32_16x16x32_bf16(Bt[n][k], At[0][k], acc[0][bj][0][n], 0, 0, 0); } } while (0)
#define PG8_WAIT_V(n) asm volatile("s_waitcnt vmcnt(" #n ")" ::: "memory")
#define PG8_WAIT_L(n) asm volatile("s_waitcnt lgkmcnt(" #n ")" ::: "memory")
#define PG8_BAR __builtin_amdgcn_s_barrier()
#define PG8_SCHED __builtin_amdgcn_sched_barrier(0)
#define PG8_GOFF(v, u) do { if (GATHER) { _Pragma("unroll") for (int _h = 0; _h < 2; ++_h) _Pragma("unroll") for (int _i = 0; _i < 2; ++_i) \
        v[_h][_i] = (unsigned)(S.arow(u, _h * HALF + sR[_i]) * g.lda + sC[_i]) * 2u; } } while (0)
#define PG8_TBODY(MMA_, ZF) { \
            const bool last = (t == nt - 2); constexpr bool zf = ZF; \
            const char* a1 = cA + (size_t)(t + 1) * kstep; \
            const char* a2 = last ? nA : cA + (size_t)(t + 2) * kstep; const char* b2 = last ? nB : cB + (size_t)(t + 2) * kstep; \
            const char* a3 = a2 + kstep; const char* b3 = b2 + kstep; \
            const unsigned x00 = (GATHER && last) ? vN[0][0] : vC[0][0], x01 = (GATHER && last) ? vN[0][1] : vC[0][1], x10 = (GATHER && last) ? vN[1][0] : vC[1][0], x11 = (GATHER && last) ? vN[1][1] : vC[1][1]; \
            PG8_LDB(B0, 0, 0); PG8_LDB(B1, 0, 1); PG8_SCHED; PG8_LDA(At, 0, 0); PG8_STAGE_A(PG8_SA(1, 1), a1, vC[1][0], vC[1][1]); \
            PG8_WAIT_V(8); PG8_WAIT_L(0); PG8_BAR; MMA_(0, 0, At, B0, zf); MMA_(0, 1, At, B1, zf); PG8_BAR; PG8_SCHED; \
            PG8_LDA(At, 0, 1); PG8_STAGE(PG8_SB(0, 0), b2, voffB); PG8_STAGE(PG8_SB(0, 1), b2 + hstepB, voffB); PG8_STAGE_A(PG8_SA(0, 0), a2, x00, x01); \
            PG8_WAIT_V(8); PG8_WAIT_L(0); PG8_BAR; MMA_(1, 0, At, B0, zf); MMA_(1, 1, At, B1, zf); PG8_BAR; PG8_SCHED; \
            PG8_LDB(B0, 1, 0); PG8_LDB(B1, 1, 1); PG8_SCHED; PG8_LDA(At, 1, 0); PG8_STAGE_A(PG8_SA(0, 1), a2, x10, x11); \
            PG8_WAIT_V(8); PG8_WAIT_L(0); PG8_BAR; MMA_(0, 0, At, B0, false); MMA_(0, 1, At, B1, false); PG8_BAR; PG8_SCHED; \
            PG8_LDA(At, 1, 1); PG8_STAGE(PG8_SB(1, 0), b3, voffB); PG8_STAGE(PG8_SB(1, 1), b3 + hstepB, voffB); PG8_STAGE_A(PG8_SA(1, 0), a3, x00, x01); \
            PG8_WAIT_V(8); PG8_WAIT_L(0); PG8_BAR; MMA_(1, 0, At, B0, false); MMA_(1, 1, At, B1, false); PG8_BAR; PG8_SCHED; \
        }
#define PG8_UNI(u) do { u.pm = __builtin_amdgcn_readfirstlane(u.pm); u.pn = __builtin_amdgcn_readfirstlane(u.pn); u.aoff = __builtin_amdgcn_readfirstlane(u.aoff); u.boff = __builtin_amdgcn_readfirstlane(u.boff); \
        u.grp = __builtin_amdgcn_readfirstlane(u.grp); u.prow = __builtin_amdgcn_readfirstlane(u.prow); } while (0)
    Unit cur, nxt; int ui = 0; float rcache[16]; int rcache_pm = -1; (void)rcache; (void)rcache_pm;
    if (!S.next(0, cur)) return;
    PG8_UNI(cur);
    constexpr bool ZC = FP8 && !Sched::THIN_META;
    f32x4 acc[2][2][4][2];
    if (!ZC)
#pragma unroll
    for (int a = 0; a < 2; ++a)
#pragma unroll
        for (int b = 0; b < 2; ++b)
#pragma unroll
            for (int m = 0; m < 4; ++m)
#pragma unroll
                for (int n = 0; n < 2; ++n) acc[a][b][m][n] = (f32x4){0.f, 0.f, 0.f, 0.f};
    const int sc8 = 0x7F7F7F7F;
    bf16x8 At[4][2], B0[2][2], B1[2][2]; v8i At8[4], B08[2], B18[2];
    const char* cA = (const char*)g.A + (GATHER ? (size_t)0 : (size_t)cur.pm * tstepA) + cur.aoff; const char* cB = (const char*)g.Bt + (size_t)cur.pn * tstepB + cur.boff;
    PG8_GOFF(vC, cur);
    PG8_STAGE(PG8_SB(0, 0), cB, voffB); PG8_STAGE(PG8_SB(0, 1), cB + hstepB, voffB); PG8_STAGE_A(PG8_SA(0, 0), cA, vC[0][0], vC[0][1]); PG8_STAGE_A(PG8_SA(0, 1), cA, vC[1][0], vC[1][1]);
    if (wr == 1) PG8_BAR;
    PG8_WAIT_V(2); PG8_BAR;
    PG8_STAGE(PG8_SB(1, 0), cB + kstep, voffB); PG8_STAGE_A(PG8_SA(1, 0), cA + kstep, vC[0][0], vC[0][1]); PG8_STAGE(PG8_SB(1, 1), cB + hstepB + kstep, voffB);
    PG8_WAIT_V(6); PG8_BAR;
    for (;;) {
        const bool has_next = S.next(ui + 1, nxt);
        PG8_UNI(nxt);
        const char* nA = has_next ? (const char*)g.A + (GATHER ? (size_t)0 : (size_t)nxt.pm * tstepA) + nxt.aoff : cA; const char* nB = has_next ? (const char*)g.Bt + (size_t)nxt.pn * tstepB + nxt.boff : cB;
        if (GATHER) { if (has_next) { PG8_GOFF(vN, nxt); } else {
#pragma unroll
            for (int _h = 0; _h < 2; ++_h)
#pragma unroll
                for (int _i = 0; _i < 2; ++_i) vN[_h][_i] = vC[_h][_i]; } }
        const bool thin = Sched::THIN_META && cur.pm == MR / 256;
        if (thin) { _Pragma("unroll 1") for (int t = 0; t < nt; t += 2) PG8_TBODY(PG8_MMA_THIN, false) }
        else if (ZC) { { const int t = 0; PG8_TBODY(PG8_MMA, true) }
            _Pragma("unroll 1") for (int t = 2; t < nt; t += 2) PG8_TBODY(PG8_MMA, false) }
        else { _Pragma("unroll 1") for (int t = 0; t < nt; t += 2) PG8_TBODY(PG8_MMA, false) }
        if (FP8) asm volatile("s_nop 15\n\ts_nop 15" ::: "memory");
        if (wr == 0) PG8_BAR;
        { int ln_; asm volatile("v_mbcnt_lo_u32_b32 %0, -1, 0\n\tv_mbcnt_hi_u32_b32 %0, -1, %0" : "=v"(ln_)); if constexpr (epi_caches_rows<Epi>::value) E(acc, cur, S, wr, wc, ln_ & 15, ln_ >> 4, rcache, rcache_pm); else E(acc, cur, S, wr, wc, ln_ & 15, ln_ >> 4); }
        if (!has_next) break;
        if (!ZC)
#pragma unroll
        for (int a = 0; a < 2; ++a)
#pragma unroll
            for (int b = 0; b < 2; ++b)
#pragma unroll
                for (int m = 0; m < 4; ++m)
#pragma unroll
                    for (int n = 0; n < 2; ++n) acc[a][b][m][n] = (f32x4){0.f, 0.f, 0.f, 0.f};
        cur = nxt; cA = nA; cB = nB; ++ui;
#pragma unroll
        for (int _h = 0; _h < 2; ++_h)
#pragma unroll
            for (int _i = 0; _i < 2; ++_i) vC[_h][_i] = vN[_h][_i];
        if (wr == 1) PG8_BAR;
    }
    PG8_WAIT_V(0);
    PG8_BAR;
#undef PG8_SA
#undef PG8_SB
#undef PG8_STAGE
#undef PG8_STAGE_A
#undef PG8_LDA
#undef PG8_LDB
#undef PG8_MMA
#undef PG8_MMA_THIN
#undef PG8_TBODY
#undef PG8_WAIT_V
#undef PG8_WAIT_L
#undef PG8_BAR
#undef PG8_SCHED
#undef PG8_GOFF
#undef PG8_UNI
}
}

#define XB_TMO      128
#define XB_XCNT(j)  (256  + 64 * (j))
#define XB_XSUB(j)  (1280 + 64 * (j))
#define XB_XGEN(j)  (2304 + 64 * (j))
#define XB_TOP      3328
#define XB_TOPGEN   3392
#define XCD_BAR_WORDS 3456
#define XB_SPIN_CAP (1u << 18)
__device__ __forceinline__ unsigned xb_ld(unsigned* p)              { return __hip_atomic_load(p, __ATOMIC_RELAXED, __HIP_MEMORY_SCOPE_AGENT); }
__device__ __forceinline__ unsigned xb_add(unsigned* p, unsigned v) { return __hip_atomic_fetch_add(p, v, __ATOMIC_RELAXED, __HIP_MEMORY_SCOPE_AGENT); }
__device__ __forceinline__ unsigned xb_xcc_id() { return (unsigned)__builtin_amdgcn_s_getreg((3 << 11) | 20) & 0xFu; }
#define XB_SPIN(cond, bar) do { unsigned _sp = 0; while (cond) { __builtin_amdgcn_s_sleep(1); \
    if ((++_sp & 255u) == 0u) { if (xb_ld(&(bar)[XB_TMO])) break; if (_sp > XB_SPIN_CAP) { atomicAdd(&(bar)[XB_TMO], 1u); break; } } } } while (0)
struct XcdBarrier { unsigned* bar; unsigned x; volatile LAS unsigned* st; };
__device__ __forceinline__ bool xb_is_t0(int wave_s) { return wave_s == 0 && __builtin_amdgcn_mbcnt_hi(~0u, __builtin_amdgcn_mbcnt_lo(~0u, 0u)) == 0u; }
__device__ __forceinline__ XcdBarrier xcd_barrier_post(unsigned* bar, volatile LAS unsigned* st, int wave_s) {
    XcdBarrier b; b.bar = bar; b.x = xb_xcc_id(); b.st = st;
    if (xb_is_t0(wave_s)) (void)xb_add(&bar[XB_XCNT(b.x)], 1u);
    return b;
}
__device__ __forceinline__ void xcd_barrier_complete(unsigned* bar, unsigned x, unsigned& nloc, unsigned& nx) {
    const unsigned G = gridDim.x * gridDim.y * gridDim.z;
    unsigned sum, cnt, mine, sp = 0u;
    for (;;) {
        sum = 0u; cnt = 0u; mine = 0u;
#pragma unroll
        for (unsigned j = 0; j < 16; ++j) { const unsigned c = xb_ld(&bar[XB_XCNT(j)]); sum += c; cnt += (c > 0u) ? 1u : 0u; mine = (j == x) ? c : mine; }
        if (sum == G) break;
        __builtin_amdgcn_s_sleep(1);
        if ((++sp & 255u) == 0u) { if (xb_ld(&bar[XB_TMO])) break; if (sp > XB_SPIN_CAP) { atomicAdd(&bar[XB_TMO], 1u); break; } }
    }
    nloc = mine > 0u ? mine : 1u; nx = cnt > 0u ? cnt : 1u;
}
__device__ __forceinline__ void xcd_barrier(const XcdBarrier& b, int wave_s) {
    asm volatile("s_waitcnt vmcnt(0)" ::: "memory");
    __syncthreads();
    if (xb_is_t0(wave_s)) {
        unsigned* bar = b.bar; asm volatile("" : "+s"(bar));
        __builtin_amdgcn_s_waitcnt(0);
        unsigned nloc = b.st[0], nx = b.st[1];
        if (nloc == 0u) { xcd_barrier_complete(bar, b.x, nloc, nx); b.st[0] = nloc; b.st[1] = nx; }
        const unsigned old = xb_add(&bar[XB_XSUB(b.x)], 1u);
        const unsigned gen = old / nloc;
        if (old + 1u == (gen + 1u) * nloc) {
            __builtin_amdgcn_fence(__ATOMIC_RELEASE, "agent");
            asm volatile("s_waitcnt vmcnt(0)" ::: "memory");
            const unsigned og = xb_add(&bar[XB_TOP], 1u);
            const unsigned tg = og / nx;
            if (og + 1u == (tg + 1u) * nx) xb_add(&bar[XB_TOPGEN], 1u);
            else XB_SPIN(xb_ld(&bar[XB_TOPGEN]) == tg, bar);
            __builtin_amdgcn_fence(__ATOMIC_ACQUIRE, "agent");
            xb_add(&bar[XB_XGEN(b.x)], 1u);
            asm volatile("s_waitcnt vmcnt(0)" ::: "memory");
        } else {
            XB_SPIN(xb_ld(&bar[XB_XGEN(b.x)]) == gen, bar);
            __builtin_amdgcn_fence(__ATOMIC_ACQUIRE, "agent");
            asm volatile("s_waitcnt vmcnt(0)" ::: "memory");
        }
    }
    __syncthreads();
}

#define CAS __attribute__((address_space(4)))
struct Frame {
    LAS unsigned char* lds;
    volatile LAS unsigned* MISC;
    gu32* ctl;
    int tid, lane, wave, G, vcu;
    const CAS unsigned char* ka;
    unsigned char* ws;
    float* out;
    bf16_t* hb;
    __device__ __forceinline__ const void* in(int i) const { return ((const void* const CAS*)ka)[i]; }
};
struct Args { const void* in[29]; float* out; unsigned char* ws; int pad0, pad1; };
__device__ __forceinline__ Frame mkframe(unsigned char* lds_raw, int wave_s) {
    Frame F; int lane_; asm volatile("v_mbcnt_lo_u32_b32 %0, -1, 0\n\tv_mbcnt_hi_u32_b32 %0, -1, %0" : "=v"(lane_));
    int tid = wave_s * 64 + lane_;
    const CAS unsigned char* ka = (const CAS unsigned char*)__builtin_amdgcn_kernarg_segment_ptr(); asm volatile("" : "+s"(ka));
    F.ka = ka; F.lds = (LAS unsigned char*)lds_raw; F.MISC = (volatile LAS unsigned*)(F.lds + MISC_OFF);
    F.tid = tid; F.lane = tid & 63; F.wave = __builtin_amdgcn_readfirstlane(tid >> 6);
    int G = gridDim.x; asm volatile("" : "+s"(G)); F.G = G; { const int bx = blockIdx.x; F.vcu = (G % 8 == 0) ? (bx % 8) * (G / 8) + bx / 8 : bx; }
    F.out = *(float* const CAS*)(ka + 232); F.ws = *(unsigned char* const CAS*)(ka + 240);
    F.hb = (bf16_t*)(F.ws + WS_HB); F.ctl = (gu32*)(F.ws + WS_CTL);
    return F;
}
enum { I_X = 0, I_POS, I_META, I_NORM_MIX_G, I_W_IN, I_Q_NORM_G, I_W_UQ, I_KV_NORM_G, I_W_UKV, I_Q_HEAD_G, I_K_HEAD_G, I_CONV_W, I_CONV_B, I_W_A, I_B_A, I_W_I, I_B_I, I_LAMBDA,
       I_ATT_G, I_RNN_G, I_W_OUT, I_NORM_FFN_G, I_FFN_GATE, I_FFN_UP, I_FFN_DOWN, I_ROUTER, I_MOE_GATE, I_MOE_UP, I_MOE_DOWN };


__device__ __forceinline__ void tr_item(const float* W, int ldw, int k0, int n0, bf16_t* WT, int ldk, int drow0, const float* gain, LAS float* scr, int lane, unsigned char* W8 = nullptr, bool only8 = false) {
    { const int lr = lane >> 3, lc = (lane & 7) * 4; f32x4 v[8]; float gn[8];
#pragma unroll
      for (int i = 0; i < 8; ++i) { const int kk = 8 * i + lr; v[i] = *(const GAS f32x4*)(W + (size_t)(k0 + kk) * ldw + n0 + lc); gn[i] = gain ? gain[k0 + kk] : 1.f; }
#pragma unroll
      for (int i = 0; i < 8; ++i) { LAS float* d = scr + (8 * i + lr) * 33 + lc; d[0] = v[i][0] * gn[i]; d[1] = v[i][1] * gn[i]; d[2] = v[i][2] * gn[i]; d[3] = v[i][3] * gn[i]; } }
    LDS_WAIT(); asm volatile("" ::: "memory");
    const int c = lane & 7;
#pragma unroll
    for (int j = 0; j < 4; ++j) { const int n = (lane >> 3) + 8 * j; const LAS float* s = scr + (8 * c) * 33 + n;
        u32x4 o; o.x = pk2(s[0 * 33], s[1 * 33]); o.y = pk2(s[2 * 33], s[3 * 33]); o.z = pk2(s[4 * 33], s[5 * 33]); o.w = pk2(s[6 * 33], s[7 * 33]);
        if (!only8) *(GAS u32x4*)(WT + (size_t)(drow0 + n) * ldk + k0 + 8 * c) = o;
        if (W8) *(GAS u32x2*)(W8 + (size_t)(drow0 + n) * ldk + k0 + 8 * c) = (u32x2){pk4_fp8(64.f * s[0 * 33], 64.f * s[1 * 33], 64.f * s[2 * 33], 64.f * s[3 * 33]), pk4_fp8(64.f * s[4 * 33], 64.f * s[5 * 33], 64.f * s[6 * 33], 64.f * s[7 * 33])}; }
    LDS_WAIT(); asm volatile("" ::: "memory");
}
__device__ __forceinline__ int tr_map(int mode, int n) {
    if (mode == 0) return n;
    if (mode == 1) return n < 384 ? n : (n < 640 ? n + 128 : (n < 672 ? n - 256 : n + 96));
    if (mode == 4) { const int h = n >> 7, d = n & 127; return d < 64 ? 256 * (h >> 2) + 128 * (d >> 5) + 32 * (h & 3) + (d & 31) : 512 + 64 * h + (d - 64); }
    return 256 * (n >> 7) + (n & 127) + (mode == 3 ? 128 : 0);
}
__device__ __forceinline__ void tr_job(const float* W, int K, int N, bf16_t* WT, const float* gain, int mode, int item, LAS float* scr, int lane, unsigned char* W8 = nullptr, bool only8 = false, int ldk8 = 0) {
    const int nblk = N / 32, kb = item / nblk, nb = item % nblk;
    tr_item(W, N, 64 * kb, 32 * nb, WT, ldk8 ? ldk8 : K, tr_map(mode, 32 * nb), gain, scr, lane, W8, only8);
}
constexpr int IT_IN = (DM / 64) * (DIN / 32), IT_UQ = (QL / 64) * (768 / 32), IT_UKV = (KVL / 64) * (1024 / 32), IT_OUT = (DM / 64) * (DM / 32), IT_MIX = IT_IN + IT_UQ + IT_UKV + IT_OUT;
constexpr int IT_DG = (DM / 64) * (DFF / 32), IT_DD = (DFF / 64) * (DM / 32), IT_DENSE = 2 * IT_DG + IT_DD;
constexpr int IT_MG = (DM / 64) * (DFE / 32), IT_MD = (DFE / 64) * (DM / 32), IT_EXP = 2 * IT_MG + IT_MD;
constexpr int JIT_SPLIT = 11264;

__device__ __forceinline__ void conv_mixer_dense_weights(const Frame& F) {
    LAS float* scr = (LAS float*)(F.lds + F.wave * 16384);
    const int gw = F.vcu * NWAVES + F.wave, NGW = F.G * NWAVES;
    unsigned char* wb = F.ws + WS_W;
    for (int it = gw; it < 4 * IT_MIX + 2 * IT_DENSE; it += NGW) {
        if (it < 4 * IT_MIX) {
            const int l = it / IT_MIX; int r = it % IT_MIX; unsigned char* lb = wb + (size_t)l * W_LAYER;
            if (r < IT_IN) { tr_job((const float*)F.in(I_W_IN) + (size_t)l * DM * DIN, DM, DIN, (bf16_t*)(lb + W_IN), (const float*)F.in(I_NORM_MIX_G) + l * DM, 1, r, scr, F.lane); continue; } r -= IT_IN;
            if (r < IT_UQ) { tr_job((const float*)F.in(I_W_UQ) + (size_t)l * QL * 768, QL, 768, (bf16_t*)(lb + W_UQ), (const float*)F.in(I_Q_NORM_G) + l * QL, 0, r, scr, F.lane); continue; } r -= IT_UQ;
            if (r < IT_UKV) { tr_job((const float*)F.in(I_W_UKV) + (size_t)l * KVL * 1024, KVL, 1024, (bf16_t*)(lb + W_UKV), (const float*)F.in(I_KV_NORM_G) + l * KVL, 4, r, scr, F.lane); continue; } r -= IT_UKV;
            {
                const int nblk = DM / 32, kb = r / nblk, nb = r % nblk; const float* gain = kb < 8 ? (const float*)F.in(I_ATT_G) + l * 512 : (const float*)F.in(I_RNN_G) + l * 512 - 512;
                tr_item((const float*)F.in(I_W_OUT) + (size_t)l * DM * DM, DM, 64 * kb, 32 * nb, (bf16_t*)(lb + W_OUT), DM, 32 * nb, gain, scr, F.lane); }
        } else {
            int r = it - 4 * IT_MIX; const int j = r / IT_DENSE; r %= IT_DENSE; unsigned char* db = wb + W_DENSE + (size_t)j * W_DENSE_STRIDE; const float* gain = (const float*)F.in(I_NORM_FFN_G) + (2 * j) * DM;
            if (r < IT_DG) { tr_job((const float*)F.in(I_FFN_GATE) + (size_t)j * DM * DFF, DM, DFF, (bf16_t*)db, gain, 2, r, scr, F.lane, F.ws + WS_W8 + (size_t)j * SZ_W8); continue; } r -= IT_DG;
            if (r < IT_DG) { tr_job((const float*)F.in(I_FFN_UP) + (size_t)j * DM * DFF, DM, DFF, (bf16_t*)db, gain, 3, r, scr, F.lane, F.ws + WS_W8 + (size_t)j * SZ_W8); continue; } r -= IT_DG;
            tr_job((const float*)F.in(I_FFN_DOWN) + (size_t)j * DFF * DM, DFF, DM, (bf16_t*)(db + SZ_UP), nullptr, 0, r, scr, F.lane, wb + W_MOE + NE * SZ_MUP8 + (size_t)j * SZ_DN8);
        }
    }
}
__device__ __forceinline__ void conv_moe_weights(const Frame& F, int j, int it0 = 0, int it1 = NE * IT_EXP, int wgr = -1, int nwg = 0, bool pad = true) {
    LAS float* scr = (LAS float*)(F.lds + F.wave * 16384);
    const int gw = (wgr < 0 ? F.vcu : wgr) * NWAVES + F.wave, NGW = (wgr < 0 ? F.G : nwg) * NWAVES;
    unsigned char* wb = F.ws + WS_W; const float* gain = (const float*)F.in(I_NORM_FFN_G) + (2 * j + 1) * DM;
    for (int it = it0 + gw; it < it1; it += NGW) {
        const int e = it / IT_EXP; int r = it % IT_EXP; const size_t eo = (size_t)(j * NE + e);
        if (r < IT_MG) { tr_job((const float*)F.in(I_MOE_GATE) + eo * DM * DFE, DM, DFE, nullptr, gain, 2, r, scr, F.lane, wb + W_MOE + (size_t)e * SZ_MUP8, true); continue; } r -= IT_MG;
        if (r < IT_MG) { tr_job((const float*)F.in(I_MOE_UP) + eo * DM * DFE, DM, DFE, nullptr, gain, 3, r, scr, F.lane, wb + W_MOE + (size_t)e * SZ_MUP8, true); continue; } r -= IT_MG;
        tr_job((const float*)F.in(I_MOE_DOWN) + eo * DFE * DM, DFE, DM, nullptr, nullptr, 0, r, scr, F.lane, wb + W_MOE_DN + (size_t)e * SZ_MDN8, true, DFE8);
    }
    if (pad) for (int i = F.vcu * NTHREADS + F.tid; i < NE * DM * 8; i += F.G * NTHREADS) *(GAS u32x4*)(wb + W_MOE_DN + (size_t)(i >> 3) * DFE8 + DFE + (i & 7) * 16) = (u32x4){0u, 0u, 0u, 0u};
}
__device__ __forceinline__ void prologue_misc(const Frame& F) {
    const int gt = F.vcu * NTHREADS + F.tid, NGT = F.G * NTHREADS;
    unsigned char* wb = F.ws + WS_W;
    for (int i = gt; i < 4 * 96 * (DM / 8); i += NGT) { const int l = i / (96 * (DM / 8)), r = i % (96 * (DM / 8)); *(GAS u32x4*)(wb + (size_t)l * W_LAYER + W_IN + ((size_t)(416 + r / (DM / 8)) * DM + (r % (DM / 8)) * 8) * 2) = (u32x4){0u, 0u, 0u, 0u}; }
    for (int i0 = gt; i0 < 4 * 4 * 256 * 256; i0 += 8 * NGT) {
        float vv[8];
#pragma unroll
        for (int q = 0; q < 8; ++q) { const int i = i0 + q * NGT; vv[q] = 0.f; if (i < 4 * 4 * 256 * 256) {
            const int kk = i & 255, rr = (i >> 8) & 255, j = (i >> 16) & 3, l = i >> 18;
            const int ch = 128 * j + (rr & 127), blk = ch >> 6, d = ch & 63, cin = 256 * (j >> 1) + kk, blk_in = cin >> 6, c = cin & 63;
            const float* Wsrc = (const float*)F.in(rr < 128 ? I_W_A : I_W_I) + (size_t)l * 8 * 64 * 64;
            if (blk_in == blk) vv[q] = Wsrc[(blk * 64 + c) * 64 + d]; } }
#pragma unroll
        for (int q = 0; q < 8; ++q) { const int i = i0 + q * NGT; if (i < 4 * 4 * 256 * 256) {
            const int kk = i & 255, rr = (i >> 8) & 255, j = (i >> 16) & 3, l = i >> 18;
            ((bf16_t*)(wb + (size_t)l * W_LAYER + W_G))[((size_t)j * 256 + rr) * 256 + kk] = (bf16_t)f2bf(vv[q]); } }
    }
    float* rope = (float*)(F.ws + WS_ROPE);
    for (int i = gt; i < MP * 16; i += NGT) {
        const int row = i >> 4, k = i & 15; int pos = 0;
        if (row < MR) pos = ((const int*)F.in(I_POS))[row] + NMETA; else if (row < MVALID) pos = row - MR;
        const double ang = (double)pos * exp(-(double)k / 16.0 * 9.210340371976184);
        double s, c; sincos(ang, &s, &c);
        rope[(size_t)row * 32 + k] = (float)c; rope[(size_t)row * 32 + 16 + k] = (float)s;
    }
}
__device__ __forceinline__ void phase_x_to_hb(const Frame& F) {
    const int gw = F.vcu * NWAVES + F.wave, NGW = F.G * NWAVES; float* ssq = (float*)(F.ws + WS_SSQ1);
    for (int row0 = 4 * gw; row0 < MP; row0 += 4 * NGW) {
        f32x4 v[4][4];
#pragma unroll
        for (int r = 0; r < 4; ++r) { const int row = row0 + r;
            if (row < MVALID) { const float* xr = row < MR ? (const float*)F.in(I_X) + (size_t)row * DM : (const float*)F.in(I_META) + (size_t)(row - MR) * DM;
#pragma unroll
                for (int j = 0; j < 4; ++j) v[r][j] = ((const GAS f32x4*)xr)[F.lane + 64 * j]; }
            else {
#pragma unroll
                for (int j = 0; j < 4; ++j) v[r][j] = (f32x4){0.f, 0.f, 0.f, 0.f}; } }
#pragma unroll
        for (int r = 0; r < 4; ++r) { const int row = row0 + r; float s = 0.f;
#pragma unroll
            for (int j = 0; j < 4; ++j) s += (v[r][j].x * v[r][j].x + v[r][j].y * v[r][j].y) + (v[r][j].z * v[r][j].z + v[r][j].w * v[r][j].w);
            s = wave_sum(s, F.lane);
            GAS u32x2* o = (GAS u32x2*)(F.hb + (size_t)row * DM);
#pragma unroll
            for (int j = 0; j < 4; ++j) o[F.lane + 64 * j] = (u32x2){pk2(v[r][j].x, v[r][j].y), pk2(v[r][j].z, v[r][j].w)};
            if (F.lane < 16) ssq[(size_t)row * 16 + F.lane] = F.lane == 0 ? s : 0.f; }
    }
}

__device__ __forceinline__ void phase_e1(const Frame& F, int l) {
    const int gw = F.vcu * NWAVES + F.wave, NGW = F.G * NWAVES;
    const bf16_t* XR = (const bf16_t*)(F.ws + T_XR); bf16_t* XC = (bf16_t*)(F.ws + T_XC);
    const float* cw = (const float*)F.in(I_CONV_W) + (size_t)l * 4 * DR; const float* cb = (const float*)F.in(I_CONV_B) + (size_t)l * DR;
    const int ch0 = F.lane * 8; float wt[4][8], bs[8];
    { const f32x4 b0 = *(const GAS f32x4*)(cb + ch0), b1 = *(const GAS f32x4*)(cb + ch0 + 4); bs[0] = b0.x; bs[1] = b0.y; bs[2] = b0.z; bs[3] = b0.w; bs[4] = b1.x; bs[5] = b1.y; bs[6] = b1.z; bs[7] = b1.w; }
#pragma unroll
    for (int j = 0; j < 4; ++j) { const f32x4 w0 = *(const GAS f32x4*)(cw + j * DR + ch0), w1 = *(const GAS f32x4*)(cw + j * DR + ch0 + 4);
        wt[j][0] = w0.x; wt[j][1] = w0.y; wt[j][2] = w0.z; wt[j][3] = w0.w; wt[j][4] = w1.x; wt[j][5] = w1.y; wt[j][6] = w1.z; wt[j][7] = w1.w; }
    for (int g = gw; g < MP / 4; g += NGW) {
        const int row0 = 4 * g;
        const int t0 = row0 < MR ? NMETA + (row0 & (SEQ - 1)) : row0 - MR; const int rb = row0 < MR ? (row0 & ~(SEQ - 1)) : 0;
        u32x4 x[7];
#pragma unroll
        for (int k = 0; k < 7; ++k) { const int tt = t0 - 3 + k; x[k] = (u32x4){0u, 0u, 0u, 0u};
            if (row0 < MVALID && tt >= 0) { const int srow = tt < NMETA ? MR + tt : rb + (tt - NMETA); x[k] = *(const GAS u32x4*)(XR + (size_t)srow * 512 + ch0); } }
#pragma unroll
        for (int r = 0; r < 4; ++r) { float acc[8];
#pragma unroll
            for (int e = 0; e < 8; ++e) acc[e] = row0 < MVALID ? bs[e] : 0.f;
#pragma unroll
            for (int j = 0; j < 4; ++j) { const u32x4 v = x[r + j];
                acc[0] += bflo(v.x) * wt[j][0]; acc[1] += bfhi(v.x) * wt[j][1]; acc[2] += bflo(v.y) * wt[j][2]; acc[3] += bfhi(v.y) * wt[j][3];
                acc[4] += bflo(v.z) * wt[j][4]; acc[5] += bfhi(v.z) * wt[j][5]; acc[6] += bflo(v.w) * wt[j][6]; acc[7] += bfhi(v.w) * wt[j][7]; }
            *(GAS u32x4*)(XC + (size_t)(row0 + r) * 512 + ch0) = (u32x4){pk2(acc[0], acc[1]), pk2(acc[2], acc[3]), pk2(acc[4], acc[5]), pk2(acc[6], acc[7])}; }
    }
}
__device__ __forceinline__ void phase_route(const Frame& F, int jm) {
    const int gw = F.vcu * NWAVES + F.wave, NGW = F.G * NWAVES, lane = F.lane;
    int* list = (int*)(F.ws + WS_LIST); f32x2* wlist = (f32x2*)(F.ws + WS_WLIST);
    const float* g = (const float*)F.in(I_NORM_FFN_G) + (2 * jm + 1) * DM; const float* wr = (const float*)F.in(I_ROUTER) + (size_t)jm * DM * NE;
    LAS f32x4* T = (LAS f32x4*)F.lds; LAS unsigned* rec = (LAS unsigned*)(F.lds + 32768); LAS unsigned* lcnt = (LAS unsigned*)(F.lds + 32768 + 17 * NWAVES * 32); LAS unsigned* gbase = lcnt + 16;
    if (F.tid < 16) lcnt[F.tid] = 0u;
    int nrec = 0;
    for (int idx = F.tid; idx < 2 * 16 * 64; idx += NTHREADS) { const int ln = idx & 63, i = (idx >> 6) & 15, half = idx >> 10, k = 512 * (i >> 3) + 8 * ln + (i & 7);
        const f32x4 w = *(const GAS f32x4*)(wr + (size_t)k * 8 + 4 * half); T[idx] = w * g[k]; }
    __syncthreads();
    u32x4 cur[2] = {(u32x4){0u, 0u, 0u, 0u}, (u32x4){0u, 0u, 0u, 0u}};
    if (gw < MVALID) { cur[0] = *(const GAS u32x4*)(F.hb + (size_t)gw * DM + 8 * lane); cur[1] = *(const GAS u32x4*)(F.hb + (size_t)gw * DM + 512 + 8 * lane); }
    for (int row = gw; row < MVALID; row += NGW) {
        float v[16]; float s = 0.f; u32x4 nxt[2] = {cur[0], cur[1]};
        if (row + NGW < MVALID) { nxt[0] = *(const GAS u32x4*)(F.hb + (size_t)(row + NGW) * DM + 8 * lane); nxt[1] = *(const GAS u32x4*)(F.hb + (size_t)(row + NGW) * DM + 512 + 8 * lane); }
#pragma unroll
        for (int j = 0; j < 2; ++j) { const u32x4 w = cur[j];
            v[8 * j] = bflo(w.x); v[8 * j + 1] = bfhi(w.x); v[8 * j + 2] = bflo(w.y); v[8 * j + 3] = bfhi(w.y); v[8 * j + 4] = bflo(w.z); v[8 * j + 5] = bfhi(w.z); v[8 * j + 6] = bflo(w.w); v[8 * j + 7] = bfhi(w.w); }
        f32x4 la = {0.f, 0.f, 0.f, 0.f}, lb = {0.f, 0.f, 0.f, 0.f};
#pragma unroll
        for (int i = 0; i < 16; ++i) { s += v[i] * v[i]; la += T[i * 64 + lane] * v[i]; lb += T[(16 + i) * 64 + lane] * v[i]; }
        const float rs = __builtin_amdgcn_rsqf(wave_sum(s, lane) * (1.f / DM) + EPS);
        f32x4 keep = (lane & 32) ? lb : la, give = (lane & 32) ? la : lb;
#pragma unroll
        for (int e = 0; e < 4; ++e) keep[e] += shfl_xor_(give[e], 32, lane);
        float k0 = (lane & 16) ? keep[2] : keep[0], k1 = (lane & 16) ? keep[3] : keep[1], g0 = (lane & 16) ? keep[0] : keep[2], g1 = (lane & 16) ? keep[1] : keep[3];
        k0 += shfl_xor_(g0, 16, lane); k1 += shfl_xor_(g1, 16, lane);
        float x = (lane & 8) ? k1 : k0; const float gx = (lane & 8) ? k0 : k1; x += shfl_xor_(gx, 8, lane);
        x += shfl_xor_(x, 4, lane); x += shfl_xor_(x, 2, lane); x += shfl_xor_(x, 1, lane);
        float lg[8];
#pragma unroll
        for (int e = 0; e < 8; ++e) lg[e] = __builtin_bit_cast(float, __builtin_amdgcn_readlane(__builtin_bit_cast(int, x), 8 * e)) * rs;
        int e0 = 0; float v0 = lg[0];
#pragma unroll
        for (int e = 1; e < 8; ++e) if (lg[e] > v0) { v0 = lg[e]; e0 = e; }
        int e1 = -1; float v1 = -3.0e38f;
#pragma unroll
        for (int e = 0; e < 8; ++e) if (e != e0 && lg[e] > v1) { v1 = lg[e]; e1 = e; }
        const float w1 = __builtin_amdgcn_rcpf(1.0f + __expf(v0 - v1)), w0 = 1.0f - w1;
        if (lane == 0) {
            const unsigned p0 = __hip_atomic_fetch_add(lcnt + e0, 1u, __ATOMIC_RELAXED, __HIP_MEMORY_SCOPE_WORKGROUP), p1 = __hip_atomic_fetch_add(lcnt + 8 + e1, 1u, __ATOMIC_RELAXED, __HIP_MEMORY_SCOPE_WORKGROUP);
            LAS unsigned* r = rec + (nrec * NWAVES + F.wave) * 8; r[0] = (unsigned)row; r[1] = (unsigned)e0 | ((unsigned)(8 + e1) << 8); r[2] = p0; r[3] = p1; r[4] = __builtin_bit_cast(unsigned, w0); r[5] = __builtin_bit_cast(unsigned, w1); r[6] = __builtin_bit_cast(unsigned, rs);
        }
        ++nrec; cur[0] = nxt[0]; cur[1] = nxt[1];
    }
    __syncthreads();
    if (F.tid < 16) gbase[F.tid] = __hip_atomic_fetch_add(F.ctl + CW_MOE + 64 * F.tid, lcnt[F.tid], RLX_AGENT);
    __syncthreads();
    for (int i = F.tid; i < 17 * NWAVES; i += NTHREADS) { const int n = i / NWAVES, w = i % NWAVES; const int row = (F.vcu * NWAVES + w) + n * NGW;
        if (row < MVALID) { const LAS unsigned* r = rec + i * 8; const unsigned g0 = r[1] & 255u, g1 = r[1] >> 8; const float rs = __builtin_bit_cast(float, r[6]);
            const size_t q0 = (size_t)g0 * MP + gbase[g0] + r[2], q1 = (size_t)g1 * MP + gbase[g1] + r[3];
            list[q0] = (int)r[0]; wlist[q0] = (f32x2){__builtin_bit_cast(float, r[4]), rs}; list[q1] = (int)r[0]; wlist[q1] = (f32x2){__builtin_bit_cast(float, r[5]), rs}; } }
    __syncthreads();
}
__device__ __forceinline__ void phase_moe_init(const Frame& F) {
    const int gt = F.vcu * NTHREADS + F.tid, NGT = F.G * NTHREADS;
    int* list = (int*)(F.ws + WS_LIST);
    for (int i = gt; i < 16 * MP / 4; i += NGT) ((GAS u32x4*)list)[i] = (u32x4){0xffffffffu, 0xffffffffu, 0xffffffffu, 0xffffffffu};
    if (gt < 16) __hip_atomic_store(F.ctl + CW_MOE + 64 * gt, 0u, RLX_AGENT);
}

struct GateC { float c8, ba, bi; };
__device__ __forceinline__ unsigned gate_ab(unsigned raw, float xc, const GateC& g) {
    const float r = sigmoidf_(bflo(raw) + g.ba), ig = sigmoidf_(bfhi(raw) + g.bi);
    const float la2 = g.c8 * r, a = __builtin_amdgcn_exp2f(la2), mult = __builtin_amdgcn_sqrtf(fmaxf(1.0f - a * a, 0.f));
    return f2bf(la2) | (f2bf(mult * ig * xc) << 16);
}
__device__ __forceinline__ GateC gate_consts(const Frame& F, int l, int c) {
    const float L = ((const float*)F.in(I_LAMBDA))[l * DR + c]; const float sp = (L > 15.f) ? __expf(-L) : log1pf(__expf(-L));
    GateC g; g.c8 = -8.0f * sp * 1.4426950408889634f; g.ba = ((const float*)F.in(I_B_A))[l * DR + c]; g.bi = ((const float*)F.in(I_B_I))[l * DR + c]; return g;
}
__device__ __forceinline__ void phase_scan1(const Frame& F, int l) {
    unsigned* AB = (unsigned*)((unsigned char*)F.out + D_AB); const bf16_t* XC = (const bf16_t*)(F.ws + T_XC); f32x2* SC = (f32x2*)(F.ws + WS_SCAN); const int c = F.tid;
    const GateC gc = gate_consts(F, l, c);
    for (int u = blockIdx.x; u < NB * SCAN_NCH; u += F.G) {
        const int b = u / SCAN_NCH, k = u % SCAN_NCH; float h = 0.f, ls = 0.f;
        if (k == 0) { unsigned ma[NMETA]; bf16_t mx[NMETA];
#pragma unroll
            for (int i = 0; i < NMETA; ++i) { const size_t r = (size_t)(MR + i) * 512 + c; ma[i] = AB[r]; mx[i] = XC[r]; }
#pragma unroll
            for (int i = 0; i < NMETA; ++i) { const unsigned w = gate_ab(ma[i], bf2f(mx[i]), gc); const float la = bflo(w); h = __builtin_amdgcn_exp2f(la) * h + bfhi(w); ls += la; } }
        const size_t r0 = (size_t)(b * SEQ + k * SCAN_CH) * 512 + c;
#pragma unroll 8
        for (int i = 0; i < SCAN_CH; ++i) { const size_t r = r0 + (size_t)i * 512; const unsigned w = gate_ab(AB[r], bf2f(XC[r]), gc); AB[r] = w; const float la = bflo(w); h = __builtin_amdgcn_exp2f(la) * h + bfhi(w); ls += la; }
        SC[(size_t)u * 512 + c] = (f32x2){ls, h};
    }
}
__device__ __forceinline__ void mix_rows(const Frame& F, int row0, int nrows) {
    const bf16_t* ATT = (const bf16_t*)(F.ws + T_ATT); bf16_t* MIX = (bf16_t*)(F.ws + WS_BUFA);
    for (int i0 = F.wave; i0 < nrows; i0 += 8 * NWAVES) {
        u32x4 at[8];
#pragma unroll
        for (int m = 0; m < 8; ++m) { const int i = i0 + m * NWAVES; at[m] = (u32x4){0u, 0u, 0u, 0u}; if (i < nrows) at[m] = *(const GAS u32x4*)(ATT + (size_t)(row0 + i) * 512 + F.lane * 8); }
#pragma unroll
        for (int m = 0; m < 8; ++m) { const int i = i0 + m * NWAVES; const int row = row0 + i; if (i < nrows) {
#pragma unroll
        for (int which = 0; which < 2; ++which) {
            const u32x4 w = which ? *(const LAS u32x4*)(F.lds + (size_t)i * 1024 + F.lane * 16) : at[m];
            float x[8] = {bflo(w.x), bfhi(w.x), bflo(w.y), bfhi(w.y), bflo(w.z), bfhi(w.z), bflo(w.w), bfhi(w.w)}; float s = 0.f;
#pragma unroll
            for (int j = 0; j < 8; ++j) s += x[j] * x[j];
            const float rs = __builtin_amdgcn_rsqf(wave_sum(s, F.lane) * (1.f / 512) + EPS);
            *(GAS u32x4*)(MIX + (size_t)row * DM + which * 512 + F.lane * 8) = (u32x4){pg8::cvt_pk_bf16(x[0] * rs, x[1] * rs), pg8::cvt_pk_bf16(x[2] * rs, x[3] * rs), pg8::cvt_pk_bf16(x[4] * rs, x[5] * rs), pg8::cvt_pk_bf16(x[6] * rs, x[7] * rs)};
        } } }
    }
}
__device__ __forceinline__ void phase_scan3_mix(const Frame& F, int l) {
    const unsigned* AB = (const unsigned*)((unsigned char*)F.out + D_AB); const bf16_t* XC = (const bf16_t*)(F.ws + T_XC); const f32x2* SC = (const f32x2*)(F.ws + WS_SCAN); const bf16_t* GT = (const bf16_t*)(F.ws + T_GT); const int c = F.tid;
    LAS bf16_t* rl = (LAS bf16_t*)F.lds;
    const GateC gc = gate_consts(F, l, c);
    for (int u = blockIdx.x; u < NB * SCAN_NCH; u += F.G) {
        const int b = u / SCAN_NCH, k = u % SCAN_NCH; float h = 0.f;
        { f32x2 sc[SCAN_NCH];
#pragma unroll
          for (int kk = 0; kk < SCAN_NCH; ++kk) { sc[kk] = (f32x2){0.f, 0.f}; if (kk < k) sc[kk] = SC[(size_t)(b * SCAN_NCH + kk) * 512 + c]; }
#pragma unroll
          for (int kk = 0; kk < SCAN_NCH; ++kk) h = __builtin_amdgcn_exp2f(sc[kk].x) * h + sc[kk].y; }
        if (k == 0) { unsigned ma[NMETA]; bf16_t mx[NMETA], mg[NMETA];
#pragma unroll
            for (int i = 0; i < NMETA; ++i) { const size_t r = (size_t)(MR + i) * 512 + c; ma[i] = AB[r]; mx[i] = XC[r]; mg[i] = GT[r]; }
#pragma unroll
            for (int i = 0; i < NMETA; ++i) { const unsigned w = gate_ab(ma[i], bf2f(mx[i]), gc); h = __builtin_amdgcn_exp2f(bflo(w)) * h + bfhi(w);
                if (b == 0) rl[i * 512 + c] = (bf16_t)f2bf(h * gelu_tanhf_(bf2f(mg[i]))); }
            if (b == 0) { __syncthreads(); mix_rows(F, MR, NMETA); __syncthreads(); } }
        const size_t r0 = (size_t)(b * SEQ + k * SCAN_CH) * 512 + c;
#pragma unroll 16
        for (int i = 0; i < SCAN_CH; ++i) { const size_t r = r0 + (size_t)i * 512; const unsigned w = AB[r]; h = __builtin_amdgcn_exp2f(bflo(w)) * h + bfhi(w); rl[i * 512 + c] = (bf16_t)f2bf(h * gelu_tanhf_(bf2f(GT[r]))); }
        __syncthreads(); mix_rows(F, b * SEQ + k * SCAN_CH, SCAN_CH); __syncthreads();
    }
}

#define EPI_ROWS_BEGIN _Pragma("unroll") for (int ai = 0; ai < 2; ++ai) _Pragma("unroll") for (int m = 0; m < 4; ++m) { const int rloc = ai * 128 + wr * 64 + m * 16 + fr; const int row = u.pm * 256 + rloc; (void)row;
#define EPI_ROWS_END }
__device__ __forceinline__ u32x4 pack8(const f32x4 a, const f32x4 b) { u32x4 w; w.x = pg8::cvt_pk_bf16(a[0], a[1]); w.y = pg8::cvt_pk_bf16(a[2], a[3]); w.z = pg8::cvt_pk_bf16(b[0], b[1]); w.w = pg8::cvt_pk_bf16(b[2], b[3]); return w; }

__device__ __forceinline__ float ssq16(const float* p) { const f32x4 a = *(const GAS f32x4*)p, b = *(const GAS f32x4*)(p + 4), c = *(const GAS f32x4*)(p + 8), d = *(const GAS f32x4*)(p + 12);
    return ((a.x + a.y) + (a.z + a.w)) + ((b.x + b.y) + (b.z + b.w)) + ((c.x + c.y) + (c.z + c.w)) + ((d.x + d.y) + (d.z + d.w)); }
__device__ __forceinline__ float ssq16c(const float* p, int fq, int lane) { const f32x4 a = *(const GAS f32x4*)(p + 4 * fq); float s = (a.x + a.y) + (a.z + a.w); s += shfl_xor_(s, 16, lane); s += shfl_xor_(s, 32, lane); return s; }
__device__ __forceinline__ f32x2 swiglu2(const f32x2 g, const f32x2 u, const f32x2 sneg, const f32x2 ws2) {
    const f32x2 t = g * sneg; const f32x2 d = (f32x2){__builtin_amdgcn_exp2f(t.x), __builtin_amdgcn_exp2f(t.y)} + (f32x2){1.0f, 1.0f};
    const f32x2 r = {__builtin_amdgcn_rcpf(d.x), __builtin_amdgcn_rcpf(d.y)}; return (g * u) * (r * ws2); }
__device__ __forceinline__ f32x4 swiglu4(const f32x4 g, const f32x4 u, float sneg, float ws2) {
    const f32x2 sn = {sneg, sneg}, w2 = {ws2, ws2};
    const f32x2 lo = swiglu2(__builtin_shufflevector(g, g, 0, 1), __builtin_shufflevector(u, u, 0, 1), sn, w2), hi = swiglu2(__builtin_shufflevector(g, g, 2, 3), __builtin_shufflevector(u, u, 2, 3), sn, w2);
    return __builtin_shufflevector(lo, hi, 0, 1, 2, 3); }
__device__ __forceinline__ float sq4(const f32x4 v) { return (v[0] * v[0] + v[1] * v[1]) + (v[2] * v[2] + v[3] * v[3]); }
struct EpiUp {
    static constexpr bool PERM = true; bf16_t* O; int ldc; const float* SSQC; int off, cnt; float invdim;
    template <class S> __device__ __forceinline__ void operator()(const f32x4 (&acc)[2][2][4][2], const pg8::Unit& u, const S&, int wr, int wc, int fr, int fq) const {
        float rsv[2][4];
        EPI_ROWS_BEGIN const float* sp = SSQC + (size_t)row * 16 + off; f32x4 t = *(const GAS f32x4*)sp; if (cnt == 8) t = t + *(const GAS f32x4*)(sp + 4);
            rsv[ai][m] = __builtin_amdgcn_rsqf(((t.x + t.y) + (t.z + t.w)) * invdim + EPS);
        EPI_ROWS_END
        EPI_ROWS_BEGIN const float rs = rsv[ai][m];
            bf16_t* rp = O + (size_t)row * ldc + u.pn * 256 + wc * 32 + 8 * fq;
#pragma unroll
            for (int bj = 0; bj < 2; ++bj) *(GAS u32x4*)(rp + bj * 128) = pack8(acc[ai][bj][m][0] * rs, acc[ai][bj][m][1] * rs);
        EPI_ROWS_END
    }
};
struct EpiKV {
    static constexpr bool PERM = true; bf16_t* Kb; bf16_t* Vb; const float* SSQC; const bf16_t* CQ; const float* rope; const float* kg;
    template <class S> __device__ __forceinline__ void operator()(const f32x4 (&acc)[2][2][4][2], const pg8::Unit& u, const S&, int wr, int wc, int fr, int fq_) const {
        int fq = fq_; asm volatile("" : "+v"(fq));
        const int lane = fr + 16 * fq;
        if (u.pn < 2) {
            const int h = 4 * u.pn + wc; float rsv[2][4], rkv[2][4];
            EPI_ROWS_BEGIN const float* sp = SSQC + (size_t)row * 16; const f32x4 t = *(const GAS f32x4*)(sp + 8); const float rs = __builtin_amdgcn_rsqf(((t.x + t.y) + (t.z + t.w)) * (1.f / KVL) + EPS), skr = sp[12];
                float ss = 0.f;
#pragma unroll
                for (int bj = 0; bj < 2; ++bj)
#pragma unroll
                    for (int n = 0; n < 2; ++n) ss += sq4(acc[ai][bj][m][n]);
                ss += shfl_xor_(ss, 16, lane); ss += shfl_xor_(ss, 32, lane);
                const float rk = __builtin_amdgcn_rsqf((ss * rs * rs + skr) * (1.f / QKH) + EPS); rsv[ai][m] = rs * rk; rkv[ai][m] = rk;
            EPI_ROWS_END
#pragma unroll
            for (int bj = 0; bj < 2; ++bj) { const f32x4 g0 = *(const GAS f32x4*)(kg + 32 * bj + 8 * fq), g1 = *(const GAS f32x4*)(kg + 32 * bj + 8 * fq + 4);
                EPI_ROWS_BEGIN *(GAS u32x4*)((unsigned char*)Kb + ((size_t)(row >> 6) * 8 + h) * 12288 + (4 * bj + fq) * 1024 + (row & 63) * 16) = pack8(acc[ai][bj][m][0] * g0 * rsv[ai][m], acc[ai][bj][m][1] * g1 * rsv[ai][m]); EPI_ROWS_END }
            { const f32x4 gr1 = *(const GAS f32x4*)(kg + 64 + 4 * fq), gr2 = *(const GAS f32x4*)(kg + 80 + 4 * fq);
              u32x2 k1v[2][4], k2v[2][4]; f32x4 ccv[2][4], snv[2][4];
              EPI_ROWS_BEGIN k1v[ai][m] = *(const GAS u32x2*)(CQ + (size_t)row * 512 + 384 + 4 * fq); k2v[ai][m] = *(const GAS u32x2*)(CQ + (size_t)row * 512 + 400 + 4 * fq);
                ccv[ai][m] = *(const GAS f32x4*)(rope + (size_t)row * 32 + 4 * fq); snv[ai][m] = *(const GAS f32x4*)(rope + (size_t)row * 32 + 16 + 4 * fq); EPI_ROWS_END
              EPI_ROWS_BEGIN const float rk = rkv[ai][m]; unsigned char* kp = (unsigned char*)Kb + ((size_t)(row >> 6) * 8 + h) * 12288 + (row & 63) * 16 + (8 + (fq >> 1)) * 1024 + (fq & 1) * 8;
                const u32x2 k1 = k1v[ai][m], k2 = k2v[ai][m]; const f32x4 cc = ccv[ai][m], sn = snv[ai][m];
                const f32x4 y1 = (f32x4){bflo(k1.x), bfhi(k1.x), bflo(k1.y), bfhi(k1.y)} * gr1 * rk, y2 = (f32x4){bflo(k2.x), bfhi(k2.x), bflo(k2.y), bfhi(k2.y)} * gr2 * rk;
                const f32x4 o1 = y1 * cc - y2 * sn, o2 = y2 * cc + y1 * sn;
                *(GAS u32x2*)kp = (u32x2){pg8::cvt_pk_bf16(o1[0], o1[1]), pg8::cvt_pk_bf16(o1[2], o1[3])}; *(GAS u32x2*)(kp + 2048) = (u32x2){pg8::cvt_pk_bf16(o2[0], o2[1]), pg8::cvt_pk_bf16(o2[2], o2[3])};
              EPI_ROWS_END }
        } else {
            float rsv[2][4];
            EPI_ROWS_BEGIN const f32x4 t = *(const GAS f32x4*)(SSQC + (size_t)row * 16 + 8); rsv[ai][m] = __builtin_amdgcn_rsqf(((t.x + t.y) + (t.z + t.w)) * (1.f / KVL) + EPS); EPI_ROWS_END
            EPI_ROWS_BEGIN const float rs = rsv[ai][m];
                unsigned char* vp = (unsigned char*)Vb + ((size_t)(row >> 6) * 8 + 4 * (u.pn - 2) + (wc >> 1)) * 8192 + ((wc & 1) * 4 + ((row & 63) >> 4)) * 1024 + ((row & 15) * 4 + fq) * 16;
#pragma unroll
                for (int bj = 0; bj < 2; ++bj) *(GAS u32x4*)(vp + bj * 2 * 8192) = pack8(acc[ai][bj][m][0] * rs, acc[ai][bj][m][1] * rs);
            EPI_ROWS_END
        }
    }
};
struct EpiProj {
    static constexpr bool PERM = true; unsigned char* ws; const float* SSQ1; float* SSQC;
    template <class S> __device__ __forceinline__ void operator()(const f32x4 (&acc)[2][2][4][2], const pg8::Unit& u, const S&, int wr, int wc, int fr, int fq) const {
        bf16_t* base; int ld, c0; const int lane = fr + 16 * fq;
        if (u.pn < 2) { base = (bf16_t*)(ws + T_CQ); ld = 512; c0 = 256 * u.pn; } else if (u.pn == 2) { base = (bf16_t*)(ws + T_CKV); ld = 256; c0 = 0; }
        else if (u.pn < 5) { base = (bf16_t*)(ws + T_XR); ld = 512; c0 = 256 * (u.pn - 3); } else { base = (bf16_t*)(ws + T_GT); ld = 512; c0 = 256 * (u.pn - 5); }
        float rsv[2][4];
        EPI_ROWS_BEGIN rsv[ai][m] = __builtin_amdgcn_rsqf(ssq16c(SSQ1 + (size_t)row * 16, fq, lane) * (1.f / DM) + EPS); EPI_ROWS_END
        EPI_ROWS_BEGIN const float rs = rsv[ai][m];
            bf16_t* rp = base + (size_t)row * ld + c0 + wc * 32 + 8 * fq; float ss = 0.f;
#pragma unroll
            for (int bj = 0; bj < 2; ++bj) { const f32x4 v0 = acc[ai][bj][m][0] * rs, v1 = acc[ai][bj][m][1] * rs; __builtin_nontemporal_store(pack8(v0, v1), (GAS u32x4*)(rp + bj * 128));
                if (u.pn != 1 || bj == 0) ss += sq4(v0) + sq4(v1); }
            if (u.pn < 3) { ss += shfl_xor_(ss, 16, lane); ss += shfl_xor_(ss, 32, lane); if (fq == 0) SSQC[(size_t)row * 16 + (u.pn == 0 ? 0 : (u.pn == 1 ? 4 : 8)) + wc] = ss; }
            if (u.pn == 1 && wc == 0) { float sk = sq4(acc[ai][1][m][0] * rs) + sq4(acc[ai][1][m][1] * rs); sk += shfl_xor_(sk, 16, lane); sk += shfl_xor_(sk, 32, lane); if (fq == 0) SSQC[(size_t)row * 16 + 12] = sk; }
        EPI_ROWS_END
    }
};
struct EpiGates {
    static constexpr bool PERM = true; unsigned* AB;
    template <class S> __device__ __forceinline__ void operator()(const f32x4 (&acc)[2][2][4][2], const pg8::Unit& u, const S&, int wr, int wc, int fr, int fq) const {
        const int ch0 = 128 * u.pn + wc * 32 + 8 * fq;
        EPI_ROWS_BEGIN GAS u32x4* op = (GAS u32x4*)(AB + (size_t)row * 512 + ch0);
#pragma unroll
            for (int n = 0; n < 2; ++n) { u32x4 o;
#pragma unroll
                for (int i = 0; i < 4; ++i) o[i] = pg8::cvt_pk_bf16(acc[ai][0][m][n][i], acc[ai][1][m][n][i]);
                op[n] = o; }
        EPI_ROWS_END
    }
};
struct EpiRes {
    static constexpr bool PERM = true; bf16_t* HB; float* SSQ; unsigned char* HB8; float ascale;
    template <class S> __device__ __forceinline__ void operator()(const f32x4 (&acc)[2][2][4][2], const pg8::Unit& u, const S&, int wr, int wc, int fr, int fq) const {
        const int col = u.pn * 256 + wc * 32 + 8 * fq, lane = fr + 16 * fq;
        u32x4 rw[2][4][2];
        EPI_ROWS_BEGIN const bf16_t* hp = HB + (size_t)row * DM + col; rw[ai][m][0] = *(const GAS u32x4*)hp; rw[ai][m][1] = *(const GAS u32x4*)(hp + 128); EPI_ROWS_END
        EPI_ROWS_BEGIN bf16_t* hp = HB + (size_t)row * DM + col; float ss = 0.f;
#pragma unroll
            for (int bj = 0; bj < 2; ++bj) { const u32x4 w = rw[ai][m][bj];
                const f32x4 v0 = (f32x4){bflo(w.x), bfhi(w.x), bflo(w.y), bfhi(w.y)} + acc[ai][bj][m][0] * ascale, v1 = (f32x4){bflo(w.z), bfhi(w.z), bflo(w.w), bfhi(w.w)} + acc[ai][bj][m][1] * ascale;
                *(GAS u32x4*)(hp + bj * 128) = pack8(v0, v1); ss += sq4(v0) + sq4(v1);
                if (HB8) *(GAS u32x2*)(HB8 + (size_t)row * DM + col + bj * 128) = (u32x2){pk4_fp8(v0[0], v0[1], v0[2], v0[3]), pk4_fp8(v1[0], v1[1], v1[2], v1[3])}; }
            ss += shfl_xor_(ss, 16, lane); ss += shfl_xor_(ss, 32, lane); if (fq == 0) SSQ[(size_t)row * 16 + u.pn * 4 + wc] = ss;
        EPI_ROWS_END
    }
};
struct EpiSwiGLU {
    static constexpr bool PERM = true; bf16_t* ACT; int ldc; const float* SSQ; float oscale; unsigned char* ACT8;
    static constexpr bool CACHE_ROWS = true;
    template <class S> __device__ __forceinline__ void operator()(const f32x4 (&acc)[2][2][4][2], const pg8::Unit& u, const S&, int wr, int wc, int fr_, int fq_, float (&rc)[16], int& rc_pm) const {
        int fr = fr_, fq = fq_; asm volatile("" : "+v"(fr), "+v"(fq));
        const int lane = fr + 16 * fq;
        if (u.pm != rc_pm) { rc_pm = u.pm;
            EPI_ROWS_BEGIN rc[ai * 4 + m] = __builtin_amdgcn_rsqf(ssq16c(SSQ + (size_t)row * 16, fq, lane) * (1.f / DM) + EPS) * oscale; EPI_ROWS_END }
        EPI_ROWS_BEGIN const float rs = rc[ai * 4 + m]; f32x4 v0, v1;
#pragma unroll
            for (int i = 0; i < 1; ++i) { const float sneg = -1.4426950408889634f * rs, ws2 = rs * rs; v0 = swiglu4(acc[ai][0][m][0], acc[ai][1][m][0], sneg, ws2); v1 = swiglu4(acc[ai][0][m][1], acc[ai][1][m][1], sneg, ws2); }
            if (ACT8) *(GAS u32x2*)(ACT8 + (size_t)row * ldc + u.pn * 128 + wc * 32 + 8 * fq) = (u32x2){pk4_fp8(v0[0], v0[1], v0[2], v0[3]), pk4_fp8(v1[0], v1[1], v1[2], v1[3])};
            else *(GAS u32x4*)(ACT + (size_t)row * ldc + u.pn * 128 + wc * 32 + 8 * fq) = pack8(v0, v1);
        EPI_ROWS_END
    }
};
struct MoeOrder {               static constexpr bool THIN_META = false;
    int nN, G, c, p0, p1; const LAS int* pfx; const int* list; const f32x2* wlist; unsigned estride;
    __device__ bool next(int i, pg8::Unit& u) const {
        const int nM = p1 - p0, nwg = nM * nN; const long L = (long)i * G + c; if (L >= nwg) return false;
        int wgid = (int)L; { const int q = nwg / pg8::NXCD, r = nwg % pg8::NXCD, xcd = wgid % pg8::NXCD, off = wgid / pg8::NXCD; wgid = (xcd < r ? xcd * (q + 1) : r * (q + 1) + (xcd - r) * q) + off; }
        const int nig = pg8::WGM * nN, gid = wgid / nig, fm = gid * pg8::WGM, gsz = (nM - fm) < pg8::WGM ? (nM - fm) : pg8::WGM;
        const int P = p0 + fm + ((wgid % nig) % gsz), pnn = (wgid % nig) / gsz; int g = 0;
#pragma unroll
        for (int q = 1; q < 16; ++q) g += (pfx[q] <= P) ? 1 : 0;
        g = __builtin_amdgcn_readfirstlane(g);
        u.pm = P; u.pn = pnn; u.grp = g; u.prow = __builtin_amdgcn_readfirstlane((P - pfx[g]) * 256); u.aoff = 0; u.boff = (unsigned)(g & 7) * estride; return true;
    }
    __device__ __forceinline__ int arow(const pg8::Unit& u, int r) const { const int idx = list[(size_t)u.grp * MP + u.prow + r]; return idx < 0 ? MP - 1 : idx; }
};
struct EpiSwiGLUMoe {
    static constexpr bool PERM = true; bf16_t* ACT;
    static constexpr bool CACHE_ROWS = true;
    __device__ __forceinline__ void operator()(const f32x4 (&acc)[2][2][4][2], const pg8::Unit& u, const MoeOrder& S, int wr, int wc, int fr, int fq, float (&rc)[16], int& rc_pm) const {
        if (u.pm != rc_pm) { rc_pm = u.pm;
            EPI_ROWS_BEGIN const size_t li = (size_t)u.grp * MP + u.prow + rloc; f32x2 wr2 = S.wlist[li]; if (S.list[li] < 0) wr2 = (f32x2){0.f, 0.f}; rc[2 * (ai * 4 + m)] = wr2.x; rc[2 * (ai * 4 + m) + 1] = wr2.y * (1.f / 64.f); EPI_ROWS_END }
        EPI_ROWS_BEGIN const float w = rc[2 * (ai * 4 + m)], rs = rc[2 * (ai * 4 + m) + 1]; f32x4 v0, v1;
#pragma unroll
            for (int i = 0; i < 1; ++i) { const float sneg = -1.4426950408889634f * rs, ws2 = w * rs * rs; v0 = swiglu4(acc[ai][0][m][0], acc[ai][1][m][0], sneg, ws2); v1 = swiglu4(acc[ai][0][m][1], acc[ai][1][m][1], sneg, ws2); }
            unsigned char* ap = (unsigned char*)ACT + (size_t)row * DFE8 + u.pn * 128 + wc * 32 + 8 * fq;
            *(GAS u32x2*)ap = (u32x2){pk4_fp8(v0[0], v0[1], v0[2], v0[3]), pk4_fp8(v1[0], v1[1], v1[2], v1[3])};
            if (u.pn == 2 * DFE / 256 - 1) *(GAS u32x2*)(ap + 128) = (u32x2){0u, 0u};
        EPI_ROWS_END
    }
};
struct EpiMoeDown {
    static constexpr bool PERM = true; bf16_t* HB; float* SSQ; float* out; int mode;
    __device__ __forceinline__ void operator()(const f32x4 (&acc)[2][2][4][2], const pg8::Unit& u, const MoeOrder& S, int wr, int wc, int fr, int fq) const {
        const int col = u.pn * 256 + wc * 32 + 8 * fq, lane = fr + 16 * fq;
        int tokv[2][4]; u32x4 rw[2][4][2];
        EPI_ROWS_BEGIN tokv[ai][m] = S.list[(size_t)u.grp * MP + u.prow + rloc]; EPI_ROWS_END
        EPI_ROWS_BEGIN const int tok = tokv[ai][m]; const int tr = tok >= 0 ? tok : MP - 1; const bf16_t* hp = HB + (size_t)tr * DM + col; rw[ai][m][0] = *(const GAS u32x4*)hp; rw[ai][m][1] = *(const GAS u32x4*)(hp + 128); EPI_ROWS_END
        EPI_ROWS_BEGIN const int tok = tokv[ai][m]; const bool ok = tok >= 0; const int tr = ok ? tok : MP - 1;
            bf16_t* hp = HB + (size_t)tr * DM + col; float ss = 0.f;
#pragma unroll
            for (int bj = 0; bj < 2; ++bj) { const u32x4 w = rw[ai][m][bj];
                const f32x4 v0 = (f32x4){bflo(w.x), bfhi(w.x), bflo(w.y), bfhi(w.y)} + acc[ai][bj][m][0] * (1.f / 64.f), v1 = (f32x4){bflo(w.z), bfhi(w.z), bflo(w.w), bfhi(w.w)} + acc[ai][bj][m][1] * (1.f / 64.f);
                ss += sq4(v0) + sq4(v1);
                if (mode == 2) { if (ok && tok < MR) { float* op = out + (size_t)tok * DM + col + bj * 128; *(GAS f32x4*)op = v0; *(GAS f32x4*)(op + 4) = v1; } }
                else if (ok) *(GAS u32x4*)(hp + bj * 128) = pack8(v0, v1); }
            if (mode == 1) { ss += shfl_xor_(ss, 16, lane); ss += shfl_xor_(ss, 32, lane); if (fq == 0 && ok) SSQ[(size_t)tok * 16 + u.pn * 4 + wc] = ss; }
        EPI_ROWS_END
    }
};
__device__ __forceinline__ void moe_prefix(const Frame& F) {
    LAS int* pfx = (LAS int*)(F.lds + LDSCTL_OFF); LAS int* npan = pfx + 32;
    __syncthreads();
    if (F.tid < 16) { const unsigned c = __hip_atomic_load(F.ctl + CW_MOE + 64 * F.tid, RLX_AGENT); npan[F.tid] = (int)((c + 255u) >> 8); }
    __syncthreads();
    if (F.tid == 0) { int s = 0;
        for (int g = 0; g < 16; ++g) { pfx[g] = s; s += npan[g]; } pfx[16] = s; }
    __syncthreads();
}

namespace att {
typedef float f32x16 __attribute__((ext_vector_type(16)));
typedef short s16x4 __attribute__((ext_vector_type(4)));
constexpr int KSLOT = 12288, VSLOT = 8192, NSLOT = 3;
constexpr int L_K = 0, L_V = NSLOT * KSLOT, L_WS = L_V + NSLOT * VSLOT, L_OST = L_WS + NWAVES * 256, L_END = L_OST + NWAVES * 4096;
static_assert(L_END <= RING_BYTES, "attention LDS");
__device__ __forceinline__ int crow(int r, int hi) { return (r & 3) + 8 * (r >> 2) + 4 * hi; }
__device__ __forceinline__ float xhalf(float v, int lane) { return shfl_xor_(v, 32, lane); }
__device__ __forceinline__ unsigned cvtpk(float lo, float hi) { typedef float f2 __attribute__((ext_vector_type(2))); typedef __bf16 b2 __attribute__((ext_vector_type(2))); f2 v = {lo, hi}; b2 b = __builtin_convertvector(v, b2); return __builtin_bit_cast(unsigned, b); }
__device__ __forceinline__ float max3f(float a, float b, float c) { float r; asm("v_max3_f32 %0, %1, %2, %3" : "=v"(r) : "v"(a), "v"(b), "v"(c)); return r; }
#define ATT_SB() __builtin_amdgcn_sched_barrier(0)

__device__ __forceinline__ void attn_unit(const Frame& F, int bb, int h, int qb, const float* qg, const float sh) {
    const bf16_t* Q = (const bf16_t*)((unsigned char*)F.out + D_Q); const bf16_t* Kb = (const bf16_t*)(F.ws + T_K); const bf16_t* Vb = (const bf16_t*)(F.ws + T_V); bf16_t* ATT = (bf16_t*)(F.ws + T_ATT);
    const int lane = F.lane, wid = F.wave, r32 = lane & 31, hi = lane >> 5;
    const bool meta = bb < 0;
    const int qrow0 = meta ? MR : bb * SEQ + qb * 256;
    const int krow_b = meta ? 0 : bb * SEQ;
    const int NT = meta ? 1 : 1 + 4 * (qb + 1);
    const int NTw = meta ? 1 : 4 * qb + 2 + (wid >> 1);
    LAS unsigned char* lds = F.lds;
    LAS float* wsf = (LAS float*)(lds + L_WS) + wid * 64;
    const unsigned kvoff = (unsigned)lane * 16u;
    const unsigned vvoff = kvoff;
#define ATT_KROW(t) ((t) == 0 ? MR : krow_b + 64 * ((t) - 1))
#define ATT_DMA_K(t, slot) do { const char* kb_ = pg8::uptr((const char*)Kb + ((size_t)(ATT_KROW(t) >> 6) * 8 + h) * 12288 + wid * 1024); const unsigned ld_ = (unsigned)__builtin_amdgcn_readfirstlane((int)(lds0 + L_K + (slot) * KSLOT + wid * 1024)); \
        glds16(kb_, kvoff, ld_); if (wid < 4) glds16(kb_ + 8192, kvoff, ld_ + 8192u); } while (0)
#define ATT_DMA_V(t, slot) do { const char* vb_ = pg8::uptr((const char*)Vb + ((size_t)(ATT_KROW(t) >> 6) * 8 + h) * 8192 + wid * 1024); \
        glds16(vb_, vvoff, (unsigned)__builtin_amdgcn_readfirstlane((int)(lds0 + L_V + (slot) * VSLOT + wid * 1024))); } while (0)
    const unsigned lds0 = (unsigned)(uintptr_t)lds;
    ATT_DMA_K(0, 0); if (NT > 1) ATT_DMA_K(1, 1); ATT_DMA_V(0, 0);
    bf16x8 qf[6];
    { const int qrow = qrow0 + wid * 32 + r32; const bf16_t* qp = Q + (size_t)qrow * 768 + h * 96 + 8 * hi; float x[6][8]; float ss = 0.f;
#pragma unroll
      for (int c = 0; c < 6; ++c) { const u32x4 w = *(const GAS u32x4*)(qp + 16 * c); x[c][0] = bflo(w.x); x[c][1] = bfhi(w.x); x[c][2] = bflo(w.y); x[c][3] = bfhi(w.y); x[c][4] = bflo(w.z); x[c][5] = bfhi(w.z); x[c][6] = bflo(w.w); x[c][7] = bfhi(w.w);
#pragma unroll
          for (int j = 0; j < 8; ++j) ss += x[c][j] * x[c][j]; }
      ss += xhalf(ss, lane);
      const float rq = __builtin_amdgcn_rsqf(ss * (1.f / QKH) + EPS) * (0.10206207261596575f * 1.4426950408889634f);
#pragma unroll
      for (int c = 0; c < 6; ++c) { const f32x4 g0 = *(const GAS f32x4*)(qg + 16 * c + 8 * hi), g1 = *(const GAS f32x4*)(qg + 16 * c + 8 * hi + 4);
#pragma unroll
          for (int j = 0; j < 4; ++j) { x[c][j] *= rq * g0[j]; x[c][4 + j] *= rq * g1[j]; } }
      const float* rp = (const float*)(F.ws + WS_ROPE) + (size_t)qrow * 32 + 8 * hi;
      const f32x4 c0 = *(const GAS f32x4*)rp, c1 = *(const GAS f32x4*)(rp + 4), s0 = *(const GAS f32x4*)(rp + 16), s1 = *(const GAS f32x4*)(rp + 20);
#pragma unroll
      for (int j = 0; j < 8; ++j) { const float cc = j < 4 ? c0[j & 3] : c1[j & 3], sn = j < 4 ? s0[j & 3] : s1[j & 3]; const float y1 = x[4][j], y2 = x[5][j]; x[4][j] = y1 * cc - y2 * sn; x[5][j] = y2 * cc + y1 * sn; }
#pragma unroll
      for (int c = 0; c < 6; ++c) { const u32x4 w = {cvtpk(x[c][0], x[c][1]), cvtpk(x[c][2], x[c][3]), cvtpk(x[c][4], x[c][5]), cvtpk(x[c][6], x[c][7])}; qf[c] = __builtin_bit_cast(bf16x8, w); } }
    asm volatile("s_waitcnt vmcnt(0)" ::: "memory");
    f32x16 o0 = {}, o1 = {}; float l_run = 0.f;
    const int qpos = meta ? r32 : qb * 256 + wid * 32 + r32;
    const LAS unsigned char* kfb = lds + L_K + hi * 1024 + r32 * 16;
    const LAS unsigned char* vfb = lds + L_V + ((lane >> 4) & 1) * 32 + (lane & 3) * 8 + (4 * hi + ((lane & 15) >> 2)) * 64;
    f32x16 A0, A1, B0, B1;
    u32x4 w0, w1, w2, w3;
#define ATT_VF(ks, d0) ({ const s16x4 lo_ = __builtin_bit_cast(s16x4, __builtin_amdgcn_ds_read_tr16_b64_v4i16((LAS s16x4*)(vp + (d0) * 4096 + (ks) * 1024))); \
        const s16x4 hh_ = __builtin_bit_cast(s16x4, __builtin_amdgcn_ds_read_tr16_b64_v4i16((LAS s16x4*)(vp + (d0) * 4096 + (ks) * 1024 + 512))); \
        (bf16x8){lo_[0], lo_[1], lo_[2], lo_[3], hh_[0], hh_[1], hh_[2], hh_[3]}; })
#define ATT_PACK4(W, P, B) do { W = (u32x4){cvtpk(P[B], P[B + 1]), cvtpk(P[B + 2], P[B + 3]), cvtpk(P[B + 4], P[B + 5]), cvtpk(P[B + 6], P[B + 7])}; \
        sacc += ((P[B] + P[B + 1]) + (P[B + 2] + P[B + 3])) + ((P[B + 4] + P[B + 5]) + (P[B + 6] + P[B + 7])); asm volatile("" : "+v"(W), "+v"(sacc)); } while (0)
#define ATT_EXP4(P, B) do { P[B] = __builtin_amdgcn_exp2f(P[B]); P[B + 1] = __builtin_amdgcn_exp2f(P[B + 1]); P[B + 2] = __builtin_amdgcn_exp2f(P[B + 2]); P[B + 3] = __builtin_amdgcn_exp2f(P[B + 3]); asm volatile("" : "+v"(P)); } while (0)
#define ATT_STEP(C0, C1, P0, P1, t, FIRST) do { \
        const LAS unsigned char* kp = kfb + kslot * KSLOT; const LAS unsigned char* vp = vfb + vslot * VSLOT; float sacc = 0.f; \
        bf16x8 ka0 = *(const LAS bf16x8*)(kp), ka1 = *(const LAS bf16x8*)(kp + 512), kb0, kb1; \
        kb0 = *(const LAS bf16x8*)(kp + 2048); kb1 = *(const LAS bf16x8*)(kp + 2048 + 512); \
        C0 = __builtin_amdgcn_mfma_f32_32x32x16_bf16(ka0, qf[0], (f32x16){}, 0, 0, 0); C1 = __builtin_amdgcn_mfma_f32_32x32x16_bf16(ka1, qf[0], (f32x16){}, 0, 0, 0); \
        ka0 = *(const LAS bf16x8*)(kp + 4096); ka1 = *(const LAS bf16x8*)(kp + 4096 + 512); if (!(FIRST)) ATT_PACK4(w0, P0, 0); ATT_SB(); \
        C0 = __builtin_amdgcn_mfma_f32_32x32x16_bf16(kb0, qf[1], C0, 0, 0, 0); C1 = __builtin_amdgcn_mfma_f32_32x32x16_bf16(kb1, qf[1], C1, 0, 0, 0); \
        kb0 = *(const LAS bf16x8*)(kp + 6144); kb1 = *(const LAS bf16x8*)(kp + 6144 + 512); if (!(FIRST)) ATT_PACK4(w1, P0, 8); ATT_SB(); \
        C0 = __builtin_amdgcn_mfma_f32_32x32x16_bf16(ka0, qf[2], C0, 0, 0, 0); C1 = __builtin_amdgcn_mfma_f32_32x32x16_bf16(ka1, qf[2], C1, 0, 0, 0); \
        ka0 = *(const LAS bf16x8*)(kp + 8192); ka1 = *(const LAS bf16x8*)(kp + 8192 + 512); if (!(FIRST)) ATT_PACK4(w2, P1, 0); ATT_SB(); \
        C0 = __builtin_amdgcn_mfma_f32_32x32x16_bf16(kb0, qf[3], C0, 0, 0, 0); C1 = __builtin_amdgcn_mfma_f32_32x32x16_bf16(kb1, qf[3], C1, 0, 0, 0); \
        kb0 = *(const LAS bf16x8*)(kp + 10240); kb1 = *(const LAS bf16x8*)(kp + 10240 + 512); if (!(FIRST)) ATT_PACK4(w3, P1, 8); ATT_SB(); \
        C0 = __builtin_amdgcn_mfma_f32_32x32x16_bf16(ka0, qf[4], C0, 0, 0, 0); C1 = __builtin_amdgcn_mfma_f32_32x32x16_bf16(ka1, qf[4], C1, 0, 0, 0); \
        bf16x8 vf0, vf1; if (!(FIRST)) { vf0 = ATT_VF(0, 0); vf1 = ATT_VF(0, 1); } ATT_SB(); \
        C0 = __builtin_amdgcn_mfma_f32_32x32x16_bf16(kb0, qf[5], C0, 0, 0, 0); C1 = __builtin_amdgcn_mfma_f32_32x32x16_bf16(kb1, qf[5], C1, 0, 0, 0); \
        l_run += sacc; \
        { const int kb_ = (t) == 0 ? 0 : 64 * ((t) - 1); \
          if ((t) == 0 || (kb_ + 63 > qb * 256 + wid * 32)) { const int lim = ((t) == 0 ? (meta ? (r32 < NMETA ? r32 : NMETA - 1) : NMETA - 1) : qpos) - kb_; \
            _Pragma("unroll") for (int r = 0; r < 16; ++r) { const int kk = crow(r, hi); if (kk > lim) C0[r] = -INFINITY; if (kk + 32 > lim) C1[r] = -INFINITY; } } } \
        if (sh != 0.f) { _Pragma("unroll") for (int r = 0; r < 16; ++r) { C0[r] -= sh; C1[r] -= sh; } } \
        ATT_SB(); \
        if (!(FIRST)) { \
            o0 = __builtin_amdgcn_mfma_f32_32x32x16_bf16(__builtin_bit_cast(bf16x8, w0), vf0, o0, 0, 0, 0); vf0 = ATT_VF(1, 0); ATT_EXP4(C0, 0); ATT_SB(); \
            o1 = __builtin_amdgcn_mfma_f32_32x32x16_bf16(__builtin_bit_cast(bf16x8, w0), vf1, o1, 0, 0, 0); vf1 = ATT_VF(1, 1); ATT_EXP4(C0, 4); ATT_SB(); \
            o0 = __builtin_amdgcn_mfma_f32_32x32x16_bf16(__builtin_bit_cast(bf16x8, w1), vf0, o0, 0, 0, 0); vf0 = ATT_VF(2, 0); ATT_EXP4(C0, 8); ATT_SB(); \
            o1 = __builtin_amdgcn_mfma_f32_32x32x16_bf16(__builtin_bit_cast(bf16x8, w1), vf1, o1, 0, 0, 0); vf1 = ATT_VF(2, 1); ATT_EXP4(C0, 12); ATT_SB(); \
            o0 = __builtin_amdgcn_mfma_f32_32x32x16_bf16(__builtin_bit_cast(bf16x8, w2), vf0, o0, 0, 0, 0); vf0 = ATT_VF(3, 0); ATT_EXP4(C1, 0); ATT_SB(); \
            o1 = __builtin_amdgcn_mfma_f32_32x32x16_bf16(__builtin_bit_cast(bf16x8, w2), vf1, o1, 0, 0, 0); vf1 = ATT_VF(3, 1); ATT_EXP4(C1, 4); ATT_SB(); \
            o0 = __builtin_amdgcn_mfma_f32_32x32x16_bf16(__builtin_bit_cast(bf16x8, w3), vf0, o0, 0, 0, 0); ATT_EXP4(C1, 8); ATT_SB(); \
            o1 = __builtin_amdgcn_mfma_f32_32x32x16_bf16(__builtin_bit_cast(bf16x8, w3), vf1, o1, 0, 0, 0); ATT_EXP4(C1, 12); ATT_SB(); \
        } else { ATT_EXP4(C0, 0); ATT_EXP4(C0, 4); ATT_EXP4(C0, 8); ATT_EXP4(C0, 12); ATT_EXP4(C1, 0); ATT_EXP4(C1, 4); ATT_EXP4(C1, 8); ATT_EXP4(C1, 12); } \
    } while (0)
#define ATT_DRAIN(P0, P1) do { const LAS unsigned char* vp = vfb + vslot * VSLOT; float sacc = 0.f; \
        ATT_PACK4(w0, P0, 0); ATT_PACK4(w1, P0, 8); ATT_PACK4(w2, P1, 0); ATT_PACK4(w3, P1, 8); l_run += sacc; \
        o0 = __builtin_amdgcn_mfma_f32_32x32x16_bf16(__builtin_bit_cast(bf16x8, w0), ATT_VF(0, 0), o0, 0, 0, 0); o1 = __builtin_amdgcn_mfma_f32_32x32x16_bf16(__builtin_bit_cast(bf16x8, w0), ATT_VF(0, 1), o1, 0, 0, 0); \
        o0 = __builtin_amdgcn_mfma_f32_32x32x16_bf16(__builtin_bit_cast(bf16x8, w1), ATT_VF(1, 0), o0, 0, 0, 0); o1 = __builtin_amdgcn_mfma_f32_32x32x16_bf16(__builtin_bit_cast(bf16x8, w1), ATT_VF(1, 1), o1, 0, 0, 0); \
        o0 = __builtin_amdgcn_mfma_f32_32x32x16_bf16(__builtin_bit_cast(bf16x8, w2), ATT_VF(2, 0), o0, 0, 0, 0); o1 = __builtin_amdgcn_mfma_f32_32x32x16_bf16(__builtin_bit_cast(bf16x8, w2), ATT_VF(2, 1), o1, 0, 0, 0); \
        o0 = __builtin_amdgcn_mfma_f32_32x32x16_bf16(__builtin_bit_cast(bf16x8, w3), ATT_VF(3, 0), o0, 0, 0, 0); o1 = __builtin_amdgcn_mfma_f32_32x32x16_bf16(__builtin_bit_cast(bf16x8, w3), ATT_VF(3, 1), o1, 0, 0, 0); \
    } while (0)
#define ATT_ITER(C0, C1, P0, P1, t, FIRST) do { \
        if ((t) + 1 < NT) { if (wid < 4) asm volatile("s_waitcnt vmcnt(3)" ::: "memory"); else asm volatile("s_waitcnt vmcnt(2)" ::: "memory"); } else asm volatile("s_waitcnt vmcnt(0)" ::: "memory"); \
        __builtin_amdgcn_s_barrier(); asm volatile("" ::: "memory"); \
        if ((t) + 2 < NT) ATT_DMA_K((t) + 2, kslot == 0 ? 2 : kslot - 1); \
        if ((t) + 1 < NT) ATT_DMA_V((t) + 1, kslot == 2 ? 0 : kslot + 1); \
        if (FIRST) { ATT_STEP(C0, C1, P0, P1, t, true); } else { if ((t) < NTw) ATT_STEP(C0, C1, P0, P1, t, false); else if ((t) == NTw) ATT_DRAIN(P0, P1); } \
        vslot = kslot; kslot = kslot == 2 ? 0 : kslot + 1; \
    } while (0)
    int kslot = 0, vslot = 2;
    ATT_ITER(A0, A1, B0, B1, 0, true);
    for (int t = 1; t <= NT; t += 2) {
        ATT_ITER(B0, B1, A0, A1, t, false);
        if (t + 1 > NT) break;
        ATT_ITER(A0, A1, B0, B1, t + 1, false);
    }
    const float lt = l_run + xhalf(l_run, lane);
    if (hi == 0) wsf[32 + r32] = 1.0f / lt;
    asm volatile("s_waitcnt lgkmcnt(0)" ::: "memory");
    LAS bf16_t* stg = (LAS bf16_t*)(lds + L_OST) + wid * 2048;
#pragma unroll
    for (int g = 0; g < 4; ++g) { const f32x4 ff = *(const LAS f32x4*)(wsf + 32 + 8 * g + 4 * hi);
#pragma unroll
        for (int e = 0; e < 4; ++e) { const int q = 8 * g + 4 * hi + e; const bool ok = !meta || (wid == 0 && q < NMETA);
            stg[q * 64 + r32] = (bf16_t)f2bf(ok ? o0[4 * g + e] * ff[e] : 0.f); stg[q * 64 + 32 + r32] = (bf16_t)f2bf(ok ? o1[4 * g + e] * ff[e] : 0.f); } }
    asm volatile("s_waitcnt lgkmcnt(0)" ::: "memory");
    bf16_t* op = ATT + (size_t)(qrow0 + wid * 32) * 512 + h * 64;
#pragma unroll
    for (int i = 0; i < 4; ++i) { int ln = lane; asm volatile("" : "+v"(ln));
        const int row = i * 8 + (ln >> 3), ch = ln & 7; const u32x4 v = *(const LAS u32x4*)(stg + row * 64 + ch * 8); *(GAS u32x4*)(op + (size_t)row * 512 + ch * 8) = v; }
    asm volatile("s_waitcnt vmcnt(0) lgkmcnt(0)" ::: "memory"); __builtin_amdgcn_s_barrier(); asm volatile("" ::: "memory");
#undef ATT_KROW
#undef ATT_DMA_K
#undef ATT_DMA_V
#undef ATT_VF
#undef ATT_PACK4
#undef ATT_EXP4
#undef ATT_STEP
#undef ATT_DRAIN
#undef ATT_ITER
}
#undef ATT_SB
}
__device__ __forceinline__ void phase_attn(const Frame& F, int l) {
    const float* qg = (const float*)F.in(I_Q_HEAD_G) + l * QKH;
    float sh; { const float* kgp = (const float*)F.in(I_K_HEAD_G) + l * QKH; float gm = 0.f, km = 0.f;
        for (int i = F.lane; i < QKH; i += 64) { gm = fmaxf(gm, fabsf(qg[i])); km = fmaxf(km, fabsf(kgp[i])); }
#pragma unroll
        for (int o = 1; o < 64; o <<= 1) { gm = fmaxf(gm, shfl_xor_(gm, o, F.lane)); km = fmaxf(km, shfl_xor_(km, o, F.lane)); }
        const float B = gm * km * 14.135f; sh = __builtin_bit_cast(float, __builtin_amdgcn_readfirstlane(__builtin_bit_cast(int, B > 90.f ? B - 64.f : 0.f))); }
    const bool fast = F.G == 256; const int v = F.vcu, c = v & 3; const int nu = fast ? (v < NH ? 5 : 4) : (NB * NH * 16 + NH - v + F.G - 1) / F.G;
    for (int i = 0; i < nu; ++i) {
        int bb, h, qb;
        if (fast) { if (i < 4) { const int bh = v >> 2; bb = bh >> 3; h = bh & 7; qb = i == 0 ? 15 - c : (i == 1 ? 8 + c : (i == 2 ? 7 - c : c)); } else { bb = -1; h = v; qb = 0; } }
        else { const int u = v + i * F.G; if (u < NB * NH * 16) { bb = u >> 7; h = (u >> 4) & 7; qb = u & 15; } else { bb = -1; h = u - NB * NH * 16; qb = 0; } }
        att::attn_unit(F, bb, h, qb, qg, sh);
    }
}

template <int MODE> __device__ __forceinline__ void mini_phase(const Frame& F, const bf16_t* A, int lda, const bf16_t* Bt, int ldb, int K, int ntasks, bf16_t* O, const float* SSQin, float* SSQout,
                                                           bf16_t* O2 = nullptr, const float* kgain = nullptr, const bf16_t* CQp = nullptr, const float* ropep = nullptr) {
    const int lane = F.lane, v = F.wave, fr = lane & 15, fq = lane >> 4, tile = v & 3, hv = v >> 2;
    LAS f32x4* part = (LAS f32x4*)F.lds; LAS float* sq = (LAS float*)(F.lds + 8192);
    for (int task = MODE == 2 ? (int)blockIdx.x : F.G - 1 - (int)blockIdx.x; task < ntasks; task += F.G) {
        int brow, kbeg, kend, acol = 0;
        if (MODE == 0) { brow = task < 8 ? 256 * (task >> 2) + 128 * (tile >> 1) + 32 * (task & 3) + 16 * (tile & 1) : 512 + 64 * (task - 8) + 16 * tile; kbeg = hv * (K / 2); kend = kbeg + K / 2; }
        else if (MODE == 2) { brow = 64 * task + 16 * tile; kbeg = hv * (K / 2); kend = kbeg + K / 2; }
        else if (MODE == 3) { const int hid = 64 * task + 16 * tile; brow = 256 * (hid >> 7) + (hid & 127) + 128 * hv; kbeg = 0; kend = K; }
        else { const int ch = 64 * task + 16 * tile, j = ch >> 7; brow = 256 * j + (ch & 127) + 128 * hv; acol = 256 * (j >> 1); kbeg = 0; kend = K; }
        const bf16_t* ap = A + (size_t)(MR + fr) * lda + acol + 8 * fq; const bf16_t* bp = Bt + (size_t)(brow + fr) * ldb + 8 * fq;
        f32x4 acc = {0.f, 0.f, 0.f, 0.f};
        for (int k = kbeg; k < kend; k += 512) {
            bf16x8 a16[16], b16[16];
#pragma unroll
            for (int i = 0; i < 16; ++i) if (k + 32 * i < kend) { a16[i] = *(const GAS bf16x8*)(ap + k + 32 * i); b16[i] = *(const GAS bf16x8*)(bp + k + 32 * i); }
#pragma unroll
            for (int i = 0; i < 16; ++i) if (k + 32 * i < kend) acc = __builtin_amdgcn_mfma_f32_16x16x32_bf16(b16[i], a16[i], acc, 0, 0, 0);
        }
        part[v * 64 + lane] = acc;
        __syncthreads();
        const int row = MR + fr; f32x4 xk = {0.f, 0.f, 0.f, 0.f};
        if (v < 4) {
            const f32x4 x = (MODE == 0 || MODE == 2) ? part[v * 64 + lane] + part[(v + 4) * 64 + lane] : part[v * 64 + lane]; const f32x4 y = part[(v + 4) * 64 + lane];
            const int col = 64 * task + 16 * tile + 4 * fq;
            if (MODE == 0) { const f32x4 t = *(const GAS f32x4*)(SSQin + (size_t)row * 16 + 8); const float rs = __builtin_amdgcn_rsqf(((t.x + t.y) + (t.z + t.w)) * (1.f / KVL) + EPS);
                xk = x * rs;
                if (task < 8) { float ss = sq4(xk); ss += shfl_xor_(ss, 16, lane); ss += shfl_xor_(ss, 32, lane); if (fq == 0) sq[tile * 16 + fr] = ss; }
                else { const int dv = 16 * tile + 4 * fq; *(GAS u32x2*)((unsigned char*)O2 + ((size_t)(row >> 6) * 8 + (task - 8)) * 8192 + ((dv >> 5) * 4 + ((row & 63) >> 4)) * 1024 + ((row & 15) * 4 + ((dv & 31) >> 3)) * 16 + (dv & 7) * 2) = (u32x2){pg8::cvt_pk_bf16(xk[0], xk[1]), pg8::cvt_pk_bf16(xk[2], xk[3])}; } }
            else if (MODE == 1) { *(GAS u32x4*)((unsigned*)O + (size_t)row * 512 + col) = (u32x4){pg8::cvt_pk_bf16(x[0], y[0]), pg8::cvt_pk_bf16(x[1], y[1]), pg8::cvt_pk_bf16(x[2], y[2]), pg8::cvt_pk_bf16(x[3], y[3])}; }
            else if (MODE == 2) { bf16_t* hp = O + (size_t)row * DM + col; const u32x2 w = *(const GAS u32x2*)hp; const f32x4 nv = (f32x4){bflo(w.x), bfhi(w.x), bflo(w.y), bfhi(w.y)} + x;
                *(GAS u32x2*)hp = (u32x2){pg8::cvt_pk_bf16(nv[0], nv[1]), pg8::cvt_pk_bf16(nv[2], nv[3])};
                if (O2) *(GAS unsigned*)((unsigned char*)O2 + (size_t)row * DM + col) = pk4_fp8(nv[0], nv[1], nv[2], nv[3]);
                float ss = sq4(nv); ss += shfl_xor_(ss, 16, lane); ss += shfl_xor_(ss, 32, lane); if (fq == 0) sq[tile * 16 + fr] = ss; }
            else { const float rs = __builtin_amdgcn_rsqf(ssq16(SSQin + (size_t)row * 16) * (1.f / DM) + EPS); f32x4 o;
#pragma unroll
                for (int i = 0; i < 4; ++i) o[i] = siluf_(x[i] * rs) * (y[i] * rs);
                *(GAS u32x2*)(O + (size_t)row * DFF + col) = (u32x2){pg8::cvt_pk_bf16(o[0], o[1]), pg8::cvt_pk_bf16(o[2], o[3])}; }
        }
        __syncthreads();
        if (MODE == 2 && v == 0 && lane < 16) SSQout[(size_t)(MR + lane) * 16 + task] = (sq[lane] + sq[16 + lane]) + (sq[32 + lane] + sq[48 + lane]);
        if (MODE == 0 && task < 8 && v < 4) {
            const float rk = __builtin_amdgcn_rsqf(((sq[fr] + sq[16 + fr]) + (sq[32 + fr] + sq[48 + fr]) + SSQin[(size_t)row * 16 + 12]) * (1.f / QKH) + EPS);
            unsigned char* kt = (unsigned char*)O + ((size_t)(row >> 6) * 8 + task) * 12288 + (row & 63) * 16; const int d0 = 16 * tile + 4 * fq; const f32x4 g = *(const GAS f32x4*)(kgain + d0); const f32x4 o = xk * g * rk;
            *(GAS u32x2*)(kt + (d0 >> 3) * 1024 + (fq & 1) * 8) = (u32x2){pg8::cvt_pk_bf16(o[0], o[1]), pg8::cvt_pk_bf16(o[2], o[3])};
            if (v == 0) { const f32x4 gr1 = *(const GAS f32x4*)(kgain + 64 + 4 * fq), gr2 = *(const GAS f32x4*)(kgain + 80 + 4 * fq);
                const u32x2 k1 = *(const GAS u32x2*)(CQp + (size_t)row * 512 + 384 + 4 * fq), k2 = *(const GAS u32x2*)(CQp + (size_t)row * 512 + 400 + 4 * fq);
                const f32x4 cc = *(const GAS f32x4*)(ropep + (size_t)row * 32 + 4 * fq), sn = *(const GAS f32x4*)(ropep + (size_t)row * 32 + 16 + 4 * fq);
                const f32x4 y1 = (f32x4){bflo(k1.x), bfhi(k1.x), bflo(k1.y), bfhi(k1.y)} * gr1 * rk, y2 = (f32x4){bflo(k2.x), bfhi(k2.x), bflo(k2.y), bfhi(k2.y)} * gr2 * rk;
                const f32x4 o1 = y1 * cc - y2 * sn, o2 = y2 * cc + y1 * sn;
                unsigned char* kr = kt + (8 + (fq >> 1)) * 1024 + (fq & 1) * 8;
                *(GAS u32x2*)kr = (u32x2){pg8::cvt_pk_bf16(o1[0], o1[1]), pg8::cvt_pk_bf16(o1[2], o1[3])}; *(GAS u32x2*)(kr + 2048) = (u32x2){pg8::cvt_pk_bf16(o2[0], o2[1]), pg8::cvt_pk_bf16(o2[2], o2[3])}; } }
    }
    __syncthreads();
}

struct PlainOrder : pg8::StaticOrder { static constexpr bool THIN_META = false; };
struct ColOrder : pg8::StaticOrder {
    static constexpr bool THIN_META = false;
    unsigned astride;
    __device__ bool next(int i, pg8::Unit& u) const { const bool ok = pg8::StaticOrder::next(i, u); if (ok) u.aoff = (unsigned)(u.pn >> 1) * astride; return ok; }
};
#define GRID_BAR() xcd_barrier(bar, wave_s)
#define FRAME() const Frame F = mkframe(lds_raw, wave_s); unsigned char* const ws = F.ws; unsigned char* const wb = ws + WS_W; unsigned char* const lw = wb + (size_t)l * W_LAYER; const int G = F.G, cid = (int)blockIdx.x; (void)wb; (void)lw; (void)G; (void)cid
template <int l> __device__ __forceinline__ void layer_phases(unsigned char* lds_raw, const XcdBarrier& bar, const int wave_s) {
    { FRAME();
      pg8::Gemm g{(const bf16_t*)(ws + WS_HB), (const bf16_t*)(lw + W_IN), DM, DM, DM}; pg8::StaticOrder S; S.init(NPANEL, NPROJ / 256, G, cid);
      EpiProj E{ws, (const float*)(ws + WS_SSQ1), (float*)(ws + WS_SSQC)}; pg8::gemm_phase<EpiProj, pg8::StaticOrder>(F.lds, g, S, E, F.tid); }
    if constexpr (l == 2) { FRAME(); constexpr int NIDLE = 256 - (NPANEL * (NPROJ / 256)) % 256;
      if (G == 256 && cid >= 256 - NIDLE) conv_moe_weights(F, 1, 0, JIT_SPLIT, cid - (256 - NIDLE), NIDLE, false); }
    GRID_BAR();
    { FRAME(); phase_e1(F, l); if (l & 1) phase_moe_init(F); if (l == 2) conv_moe_weights(F, 1, F.G == 256 ? JIT_SPLIT : 0); }
    GRID_BAR();
    { FRAME(); pg8::Gemm g{(const bf16_t*)(ws + T_CQ), (const bf16_t*)(lw + W_UQ), 512, QL, QL}; pg8::StaticOrder S; S.init(NPANEL, 768 / 256, G, cid);
      EpiUp E{(bf16_t*)((unsigned char*)F.out + D_Q), 768, (const float*)(ws + WS_SSQC), 0, 8, 1.f / QL}; pg8::gemm_phase<EpiUp, pg8::StaticOrder>(F.lds, g, S, E, F.tid); }
    { FRAME(); pg8::Gemm g{(const bf16_t*)(ws + T_CKV), (const bf16_t*)(lw + W_UKV), 256, KVL, KVL}; PlainOrder S; S.init(NPANEL - 1, 1024 / 256, G, cid);
      const float* kg = (const float*)F.in(I_K_HEAD_G) + l * QKH;
      EpiKV E{(bf16_t*)(ws + T_K), (bf16_t*)(ws + T_V), (const float*)(ws + WS_SSQC), (const bf16_t*)(ws + T_CQ), (const float*)(ws + WS_ROPE), kg}; pg8::gemm_phase<EpiKV, PlainOrder>(F.lds, g, S, E, F.tid); }
      { FRAME(); const float* kg = (const float*)F.in(I_K_HEAD_G) + l * QKH; mini_phase<0>(F, (const bf16_t*)(ws + T_CKV), 256, (const bf16_t*)(lw + W_UKV), KVL, KVL, 16, (bf16_t*)(ws + T_K), (const float*)(ws + WS_SSQC), nullptr, (bf16_t*)(ws + T_V), kg, (const bf16_t*)(ws + T_CQ), (const float*)(ws + WS_ROPE)); }
    { FRAME(); pg8::Gemm g{(const bf16_t*)(ws + T_XC), (const bf16_t*)(lw + W_G), 512, 256, 256}; ColOrder S; S.init(NPANEL - 1, 4, G, cid); S.astride = 512;
      EpiGates E{(unsigned*)((unsigned char*)F.out + D_AB)}; pg8::gemm_phase<EpiGates, ColOrder>(F.lds, g, S, E, F.tid); }
      { FRAME(); mini_phase<1>(F, (const bf16_t*)(ws + T_XC), 512, (const bf16_t*)(lw + W_G), 256, 256, 8, (bf16_t*)((unsigned char*)F.out + D_AB), nullptr, nullptr); }
    GRID_BAR();
    { FRAME(); phase_scan1(F, l); } { FRAME(); phase_attn(F, l); }
    GRID_BAR();
    { FRAME(); phase_scan3_mix(F, l); }
    GRID_BAR();
    { FRAME();
      pg8::Gemm g{(const bf16_t*)(ws + WS_BUFA), (const bf16_t*)(lw + W_OUT), DM, DM, DM}; PlainOrder S; S.init(NPANEL - 1, DM / 256, G, cid);
      EpiRes E{F.hb, (float*)(ws + WS_SSQ2), ws + WS_HB8, 1.f}; pg8::gemm_phase<EpiRes, PlainOrder>(F.lds, g, S, E, F.tid); }
      { FRAME(); mini_phase<2>(F, (const bf16_t*)(ws + WS_BUFA), DM, (const bf16_t*)(lw + W_OUT), DM, DM, 16, F.hb, nullptr, (float*)(ws + WS_SSQ2), (bf16_t*)(ws + WS_HB8)); }
    GRID_BAR();
    if constexpr (!(l & 1)) {
        constexpr int j = l >> 1;
        { FRAME(); unsigned char* dw = wb + W_DENSE + (size_t)j * W_DENSE_STRIDE;
          pg8::Gemm g{(const bf16_t*)(ws + WS_HB8), (const bf16_t*)(ws + WS_W8 + (size_t)j * SZ_W8), DM / 2, DM / 2, DM / 2}; PlainOrder S; S.init(NPANEL - 1, 2 * DFF / 256, G, cid);
          EpiSwiGLU E{(bf16_t*)(ws + T_ACT), DFF, (const float*)(ws + WS_SSQ2), 1.f / 64.f, ws + T_ACT}; pg8::gemm_phase<EpiSwiGLU, PlainOrder, false, true>(F.lds, g, S, E, F.tid); }
          { FRAME(); unsigned char* dw = wb + W_DENSE + (size_t)j * W_DENSE_STRIDE; mini_phase<3>(F, (const bf16_t*)(ws + WS_HB), DM, (const bf16_t*)dw, DM, DM, DFF / 64, (bf16_t*)(ws + T_ACT), (const float*)(ws + WS_SSQ2), nullptr); }
        GRID_BAR();
        { FRAME(); unsigned char* dw = wb + W_DENSE + (size_t)j * W_DENSE_STRIDE;
          pg8::Gemm g{(const bf16_t*)(ws + T_ACT), (const bf16_t*)(wb + W_MOE + NE * SZ_MUP8 + (size_t)j * SZ_DN8), DFF / 2, DFF / 2, DFF / 2}; PlainOrder S; S.init(NPANEL - 1, DM / 256, G, cid);
          EpiRes E{F.hb, (float*)(ws + WS_SSQ1), nullptr, 1.f / 64.f}; pg8::gemm_phase<EpiRes, PlainOrder, false, true>(F.lds, g, S, E, F.tid); }
          { FRAME(); unsigned char* dw = wb + W_DENSE + (size_t)j * W_DENSE_STRIDE; mini_phase<2>(F, (const bf16_t*)(ws + T_ACT), DFF, (const bf16_t*)(dw + SZ_UP), DFF, DFF, 16, F.hb, nullptr, (float*)(ws + WS_SSQ1)); }
        GRID_BAR();
    } else {
        constexpr int j = l >> 1;
        { FRAME(); phase_route(F, j); }
        GRID_BAR();
        { FRAME(); const LAS int* pfx = (const LAS int*)(F.lds + LDSCTL_OFF);
          moe_prefix(F);
          pg8::Gemm g{(const bf16_t*)(ws + WS_HB8), (const bf16_t*)(wb + W_MOE), DM / 2, DM / 2, DM / 2};
          MoeOrder S{2 * DFE / 256, G, cid, 0, pfx[16], pfx, (const int*)(ws + WS_LIST), (const f32x2*)(ws + WS_WLIST), (unsigned)SZ_MUP8};
          EpiSwiGLUMoe E{(bf16_t*)(ws + T_ACT)}; pg8::gemm_phase<EpiSwiGLUMoe, MoeOrder, true, true>(F.lds, g, S, E, F.tid); }
        GRID_BAR();
        { FRAME(); const LAS int* pfx = (const LAS int*)(F.lds + LDSCTL_OFF);
          moe_prefix(F);
          pg8::Gemm g{(const bf16_t*)(ws + T_ACT), (const bf16_t*)(wb + W_MOE_DN), DFE8 / 2, DFE8 / 2, DFE8 / 2};
          MoeOrder S{DM / 256, G, cid, 0, pfx[8], pfx, (const int*)(ws + WS_LIST), (const f32x2*)(ws + WS_WLIST), (unsigned)SZ_MDN8};
          EpiMoeDown E{F.hb, (float*)(ws + WS_SSQ1), F.out, 0}; pg8::gemm_phase<EpiMoeDown, MoeOrder, false, true>(F.lds, g, S, E, F.tid); }
        GRID_BAR();
        { FRAME(); const LAS int* pfx = (const LAS int*)(F.lds + LDSCTL_OFF);
          moe_prefix(F);
          pg8::Gemm g{(const bf16_t*)(ws + T_ACT), (const bf16_t*)(wb + W_MOE_DN), DFE8 / 2, DFE8 / 2, DFE8 / 2};
          MoeOrder S{DM / 256, G, cid, pfx[8], pfx[16], pfx, (const int*)(ws + WS_LIST), (const f32x2*)(ws + WS_WLIST), (unsigned)SZ_MDN8};
          EpiMoeDown E{F.hb, (float*)(ws + WS_SSQ1), F.out, l == DEPTH - 1 ? 2 : 1}; pg8::gemm_phase<EpiMoeDown, MoeOrder, false, true>(F.lds, g, S, E, F.tid); }
        if (l != DEPTH - 1) GRID_BAR();
    }
}
__global__ void __launch_bounds__(NTHREADS, 2) trunk_fwd(Args args) {
    extern __shared__ __attribute__((aligned(16))) unsigned char lds_raw[];
    const int wave_s = __builtin_amdgcn_readfirstlane((int)threadIdx.x >> 6);
    {
        LAS unsigned char* l3 = (LAS unsigned char*)lds_raw; const int t0 = wave_s * 64 + (int)__builtin_amdgcn_mbcnt_hi(~0u, __builtin_amdgcn_mbcnt_lo(~0u, 0u));
        for (int u = t0; u < (LDS_BYTES - LDSCTL_OFF) / 4; u += NTHREADS) ((LAS unsigned*)(l3 + LDSCTL_OFF))[u] = 0u;
        __syncthreads();
    }
    XcdBarrier bar = xcd_barrier_post((unsigned*)(args.ws + WS_CTL) + CW_BAR, (volatile LAS unsigned*)((LAS unsigned char*)lds_raw + MISC_OFF) + 8, wave_s);
    { const int l = 0; FRAME(); conv_mixer_dense_weights(F); conv_moe_weights(F, 0); prologue_misc(F); phase_x_to_hb(F); }
    GRID_BAR();
    layer_phases<0>(lds_raw, bar, wave_s);
    layer_phases<1>(lds_raw, bar, wave_s);
    layer_phases<2>(lds_raw, bar, wave_s);
    layer_phases<3>(lds_raw, bar, wave_s);
}
#undef GRID_BAR
#undef FRAME

extern "C" void kernel_launch(void* const* d_in, const int* in_sizes, int n_in, void* d_out, int out_size, void* d_ws, size_t ws_size, hipStream_t stream) {
    static int grid = 0;
    if (grid == 0) {
        if (n_in != 29 || out_size != MR * DM || ws_size < WS_END) { fprintf(stderr, "kernel_launch: unexpected shapes (n_in %d out %d ws %zu)\n", n_in, out_size, ws_size); grid = -1; return; }
        int dev = 0, cus = 0, per_cu = 0;
        if (hipGetDevice(&dev) != hipSuccess || hipDeviceGetAttribute(&cus, hipDeviceAttributeMultiprocessorCount, dev) != hipSuccess) { grid = -1; return; }
        if (hipFuncSetAttribute((const void*)trunk_fwd, hipFuncAttributeMaxDynamicSharedMemorySize, LDS_BYTES) != hipSuccess) { fprintf(stderr, "kernel_launch: hipFuncSetAttribute failed\n"); grid = -1; return; }
        if (hipOccupancyMaxActiveBlocksPerMultiprocessor(&per_cu, (const void*)trunk_fwd, NTHREADS, LDS_BYTES) != hipSuccess || per_cu < 1) { fprintf(stderr, "kernel_launch: occupancy query says %d\n", per_cu); }
        (void)hipGetLastError();
        grid = cus;
    }
    if (grid < 0) return;
    (void)hipMemsetAsync((char*)d_ws + WS_CTL, 0, CTL_ZERO_BYTES, stream);
    Args a{};
    for (int i = 0; i < 29; ++i) a.in[i] = d_in[i];
    a.out = (float*)d_out; a.ws = (unsigned char*)d_ws;
    hipLaunchKernelGGL(trunk_fwd, dim3(grid), dim3(NTHREADS), LDS_BYTES, stream, a);
}
```

```cpp
#include <hip/hip_runtime.h>
#include <cstdio>
#include <cstdint>
#include <type_traits>

#define LAS __attribute__((address_space(3)))
#define GAS __attribute__((address_space(1)))
typedef unsigned short bf16_t;
typedef short bf16x8 __attribute__((ext_vector_type(8)));
typedef float f32x4 __attribute__((ext_vector_type(4)));
typedef float f32x2 __attribute__((ext_vector_type(2)));
typedef unsigned u32x4 __attribute__((ext_vector_type(4)));
typedef unsigned u32x2 __attribute__((ext_vector_type(2)));
typedef GAS unsigned gu32;

constexpr int NB = 8, SEQ = 4096, NMETA = 16, DM = 1024, DEPTH = 4;
constexpr int MR = NB * SEQ;
constexpr int MP = MR + 256;
constexpr int NPANEL = MP / 256;
constexpr int MVALID = MR + NMETA;
constexpr int QL = 384, KVL = 256, ROPE = 32, DR = 512, DIN = 1696;
constexpr int NH = 8, QKN = 64, QKH = 96, VH = 64;
constexpr int DFF = 2816, NE = 8, DFE = 1408;
constexpr int NPROJ = 1792;
constexpr float EPS = 1e-6f;
constexpr int NWAVES = 8, NTHREADS = 512;
constexpr int SCAN_CH = 128, SCAN_NCH = SEQ / SCAN_CH;

constexpr size_t MiB = 1u << 20, QMiB = 1u << 18;
constexpr size_t WS_CTL = 0, CTL_ZERO_BYTES = 1 * MiB;
constexpr size_t WS_ROPE = 4 * QMiB;
constexpr size_t WS_LIST = 21 * QMiB;
constexpr size_t WS_WLIST = 30 * QMiB;
constexpr size_t WS_SCAN = 47 * QMiB;
constexpr size_t WS_SSQ1 = 51 * QMiB;
constexpr size_t WS_SSQ2 = 60 * QMiB;
constexpr size_t WS_SSQC = 69 * QMiB;
constexpr size_t WS_W = 20 * MiB;
constexpr size_t WS_BUFA = 148 * MiB;
constexpr size_t WS_T = 213 * MiB;
constexpr size_t WS_HB = 400 * MiB;
constexpr size_t WS_W8 = 465 * MiB;
constexpr size_t SZ_W8 = (size_t)2 * DFF * DM;
constexpr size_t WS_HB8 = 476 * MiB;
constexpr size_t WS_END = 509 * MiB;
static_assert(WS_W8 + 2 * SZ_W8 <= WS_HB8 && WS_HB8 + (size_t)MP * DM <= WS_END, "fp8 buffers");
constexpr size_t SZ512 = (size_t)MP * 512 * 2;
static_assert(WS_ROPE + (size_t)MP * 32 * 4 <= WS_LIST && WS_LIST + (size_t)16 * MP * 4 <= WS_WLIST && WS_WLIST + (size_t)16 * MP * 8 <= WS_SCAN && WS_SCAN + MiB <= WS_SSQ1 && WS_SSQ1 + (size_t)MP * 64 <= WS_SSQ2 && WS_SSQ2 + (size_t)MP * 64 <= WS_SSQC && WS_SSQC + (size_t)MP * 64 <= WS_W, "small tables");
constexpr size_t T_CQ = WS_T, T_CKV = T_CQ + SZ512, T_XR = T_CKV + SZ512 / 2, T_XC = T_XR + SZ512, T_GT = T_XC + SZ512, T_RNN = T_GT + SZ512, T_ENDMIX = T_RNN + SZ512;
constexpr size_t T_K = WS_BUFA;
constexpr size_t T_V = T_XR;
constexpr size_t T_ATT = T_CQ;
constexpr size_t T_ACT = WS_T;
static_assert(T_ENDMIX <= WS_HB, "mixer temporaries fit");
static_assert(T_ACT + (size_t)272 * 256 * DFE * 2 <= WS_HB && T_ACT + (size_t)MP * DFF * 2 <= WS_HB && WS_HB + (size_t)MP * DM * 2 <= WS_END, "FFN activations + residual fit");
constexpr size_t D_Q = 0, D_AB = (size_t)MP * 768 * 2;
static_assert(D_AB + (size_t)MP * 512 * 4 <= (size_t)MR * DM * 4, "d_out scratch");
constexpr size_t W_IN = 0, SZ_IN = (size_t)NPROJ * DM * 2;
constexpr size_t W_UQ = W_IN + SZ_IN, SZ_UQ = (size_t)768 * QL * 2;
constexpr size_t W_UKV = W_UQ + SZ_UQ, SZ_UKV = (size_t)1024 * KVL * 2;
constexpr size_t W_G = W_UKV + SZ_UKV, SZ_G = (size_t)1024 * 256 * 2;
constexpr size_t W_OUT = W_G + SZ_G, SZ_OUT = (size_t)DM * DM * 2;
constexpr size_t W_LAYER = W_OUT + SZ_OUT;
constexpr size_t W_DENSE = 4 * W_LAYER, SZ_UP = (size_t)2 * DFF * DM * 2, SZ_DN = (size_t)DM * DFF * 2, W_DENSE_STRIDE = SZ_UP + SZ_DN;
constexpr size_t W_MOE = W_DENSE + 2 * W_DENSE_STRIDE, SZ_MUP = (size_t)2 * DFE * DM * 2, SZ_MDN = (size_t)DM * DFE * 2;
constexpr int DFE8 = 1536;
constexpr size_t SZ_MDN8 = (size_t)DM * DFE8;
constexpr size_t SZ_MUP8 = (size_t)2 * DFE * DM;
constexpr size_t SZ_DN8 = (size_t)DM * DFF;
constexpr size_t W_MOE_DN = W_MOE + NE * SZ_MUP, W_END = W_MOE_DN + NE * SZ_MDN;
static_assert(WS_W + W_END <= WS_BUFA, "weights fit");
static_assert(NE * SZ_MUP8 + 2 * SZ_DN8 <= NE * SZ_MUP, "fp8 expert up weights + fp8 dense down weights share the (bf16-sized) MoE up-weight region");
constexpr int CW_TMO = 0, CW_BAR = 4096, CW_MOE = 16384;

constexpr int RING_BYTES = 131072, LDSCTL_OFF = RING_BYTES, MISC_OFF = LDSCTL_OFF + 320, LDS_BYTES = 147456;

#define RLX_AGENT __ATOMIC_RELAXED, __HIP_MEMORY_SCOPE_AGENT
#define LDS_WAIT() asm volatile("s_waitcnt lgkmcnt(0)" ::: "memory")
#define VM_WAIT() asm volatile("s_waitcnt vmcnt(0)" ::: "memory")
__device__ __forceinline__ unsigned f2bf(float f) { unsigned u = __builtin_bit_cast(unsigned, f); return (u + 0x7fffu + ((u >> 16) & 1u)) >> 16; }
__device__ __forceinline__ unsigned pk2(float lo, float hi) { return f2bf(lo) | (f2bf(hi) << 16); }
__device__ __forceinline__ unsigned pk4_fp8(float a, float b, float c, float d) { int r = __builtin_amdgcn_cvt_pk_fp8_f32(a, b, 0, false); r = __builtin_amdgcn_cvt_pk_fp8_f32(c, d, r, true); return (unsigned)r; }
__device__ __forceinline__ float bflo(unsigned w) { return __builtin_bit_cast(float, w << 16); }
__device__ __forceinline__ float bfhi(unsigned w) { return __builtin_bit_cast(float, w & 0xffff0000u); }
__device__ __forceinline__ float bf2f(bf16_t h) { return __builtin_bit_cast(float, (unsigned)h << 16); }
__device__ __forceinline__ float shfl_xor_(float v, int mask, int lane) {
    const int x = __builtin_bit_cast(int, v);
    if (mask == 1) return __builtin_bit_cast(float, __builtin_amdgcn_update_dpp(0, x, 0xB1, 0xF, 0xF, true));
    if (mask == 2) return __builtin_bit_cast(float, __builtin_amdgcn_update_dpp(0, x, 0x4E, 0xF, 0xF, true));
    if (mask == 4) { int t = __builtin_amdgcn_update_dpp(x, x, 0x104, 0xF, 0x5, false); t = __builtin_amdgcn_update_dpp(t, x, 0x114, 0xF, 0xA, false); return __builtin_bit_cast(float, t); }
    if (mask == 8) return __builtin_bit_cast(float, __builtin_amdgcn_update_dpp(0, x, 0x128, 0xF, 0xF, true));
    if (mask == 16) { const auto r = __builtin_amdgcn_permlane16_swap((unsigned)x, (unsigned)x, false, false); return __builtin_bit_cast(float, (lane & 16) ? r[0] : r[1]); }
    const auto r = __builtin_amdgcn_permlane32_swap((unsigned)x, (unsigned)x, false, false); return __builtin_bit_cast(float, (lane & 32) ? r[0] : r[1]);
}
__device__ __forceinline__ float wave_sum(float v, int lane) {
#pragma unroll
    for (int o = 1; o < 64; o <<= 1) v += shfl_xor_(v, o, lane);
    return v;
}
__device__ __forceinline__ float sigmoidf_(float x) { return __builtin_amdgcn_rcpf(1.0f + __builtin_amdgcn_exp2f(-1.4426950408889634f * x)); }
__device__ __forceinline__ float siluf_(float x) { return x * __builtin_amdgcn_rcpf(1.0f + __builtin_amdgcn_exp2f(-1.4426950408889634f * x)); }
__device__ __forceinline__ float gelu_tanhf_(float x) { const float z = 0.7978845608028654f * (x + 0.044715f * x * x * x); return x * __builtin_amdgcn_rcpf(1.0f + __builtin_amdgcn_exp2f(-2.8853900817779268f * z)); }

__device__ __forceinline__ void glds16(const char* sbase, unsigned voff, unsigned lds_dst) { unsigned keep;
    asm volatile("s_mov_b32 %0, m0\n\ts_mov_b32 m0, %3\n\ts_nop 0\n\tglobal_load_lds_dwordx4 %1, %2\n\ts_mov_b32 m0, %0" : "=&s"(keep) : "v"(voff), "s"(sbase), "s"(lds_dst) : "memory"); }
namespace pg8 {
constexpr int BM = 256, BK = 64, HALF = 128, HTB = HALF * BK * 2, NXCD = 8, WGM = 8;
__host__ __device__ __forceinline__ int lds_byte(int r, int c) { const int st = (r >> 4) * 2 + (c >> 5), rr = r & 15, cc = c & 31, ob = rr * 64 + cc * 2; return st * 1024 + (ob ^ (((ob >> 9) & 1) << 5)); }
__host__ __device__ __forceinline__ void stage_rc(int b, int& R, int& C) { const int st = b / 1024, sb = b % 1024, swz = sb ^ (((sb >> 9) & 1) << 5); R = (st >> 1) * 16 + swz / 64; C = (st & 1) * 32 + (swz % 64) / 2; }
__host__ __device__ __forceinline__ int perm32(int rho) { const int n = rho >> 4, i = rho & 15; return 8 * (i >> 2) + 4 * n + (i & 3); }

struct Unit { int pm, pn; unsigned aoff, boff; int grp, prow; };
struct Gemm { const bf16_t* A; const bf16_t* Bt; int lda, ldb, K; };

struct StaticOrder {
    static constexpr bool THIN_META = true;
    int nM, nN, nwg, G, c;
    __device__ void init(int nM_, int nN_, int G_, int c_) { nM = nM_; nN = nN_; nwg = nM * nN; G = G_; c = c_; }
    __device__ bool next(int i, Unit& u) const {
        const long L = (long)i * G + c; if (L >= nwg) return false;
        int wgid = (int)L; { const int q = nwg / NXCD, r = nwg % NXCD, xcd = wgid % NXCD, off = wgid / NXCD; wgid = (xcd < r ? xcd * (q + 1) : r * (q + 1) + (xcd - r) * q) + off; }
        const int nig = WGM * nN, gid = wgid / nig, fm = gid * WGM, gsz = (nM - fm) < WGM ? (nM - fm) : WGM;
        u.pm = fm + ((wgid % nig) % gsz); u.pn = (wgid % nig) / gsz; u.aoff = 0; u.boff = 0; u.grp = 0; u.prow = 0; return true;
    }
    __device__ __forceinline__ int arow(const Unit&, int) const { return 0; }
};

__device__ __forceinline__ const char* uptr(const char* p) {
    const unsigned long long v = (unsigned long long)p; const unsigned lo = __builtin_amdgcn_readfirstlane((unsigned)v), hi = __builtin_amdgcn_readfirstlane((unsigned)(v >> 32));
    return (const char*)(((unsigned long long)hi << 32) | lo); }
typedef int v8i __attribute__((ext_vector_type(8)));
typedef int v4i __attribute__((ext_vector_type(4)));
__device__ __forceinline__ v8i fp8cat(const bf16x8 a, const bf16x8 b) { return __builtin_shufflevector(__builtin_bit_cast(v4i, a), __builtin_bit_cast(v4i, b), 0, 1, 2, 3, 4, 5, 6, 7); }
__device__ __forceinline__ unsigned cvt_pk_bf16(float lo, float hi) { unsigned r; asm volatile("v_cvt_pk_bf16_f32 %0, %1, %2" : "=v"(r) : "v"(lo), "v"(hi)); return r; }

template <class T, class = void> struct epi_caches_rows : std::false_type {};
template <class T> struct epi_caches_rows<T, std::void_t<decltype(T::CACHE_ROWS)>> : std::true_type {};
template <class Epi, class Sched, bool GATHER = false, bool FP8 = false>
__device__ __forceinline__ void gemm_phase(LAS unsigned char* lds, const Gemm g, const Sched& S, const Epi& E, int tid_) {
    asm volatile("" : "+v"(tid_));
    const int tid = tid_, wid = __builtin_amdgcn_readfirstlane(tid >> 6), lane = tid & 63, wr = wid >> 2, wc = wid & 3, fr = lane & 15, fq = lane >> 4;
    const int K = g.K, nt = K / BK;
    unsigned voffB[2], vC[2][2], vN[2][2]; int sR[2], sC[2];
    const size_t kstep = (size_t)(BK * 2);
    const size_t hstepA = (size_t)HALF * g.lda * 2, tstepA = 2 * hstepA, hstepB = (size_t)HALF * g.ldb * 2, tstepB = 2 * hstepB;
#pragma unroll
    for (int i = 0; i < 2; ++i) { int R, C; stage_rc(tid * 16 + i * 8192, R, C); const int Rb = Epi::PERM ? ((R & ~31) + perm32(R & 31)) : R; sR[i] = R; sC[i] = C;
        voffB[i] = (unsigned)(Rb * g.ldb + C) * 2u;
        if (!GATHER) { vC[0][i] = (unsigned)(R * g.lda + C) * 2u; vC[1][i] = vC[0][i]; vN[0][i] = vC[0][i]; vN[1][i] = vC[0][i]; } }
    const unsigned ldsw = (unsigned)wid * 1024u, lds0 = (unsigned)(uintptr_t)lds;
    const int aoff = lds_byte(wr * 64 + fr, fq * 8), boff = lds_byte(wc * 32 + fr, fq * 8);
#define PG8_SA(b, h) (((b) * 2 + (h)) * HTB)
#define PG8_SB(b, h) ((4 + (b) * 2 + (h)) * HTB)
#define PG8_STAGE(bufoff, gbase, voff) do { const char* _gb = uptr((const char*)(gbase)); const unsigned _ld = (unsigned)__builtin_amdgcn_readfirstlane((int)(lds0 + (bufoff) + ldsw)); \
        glds16(_gb, (voff)[0], _ld); glds16(_gb, (voff)[1], _ld + 8192u); } while (0)
#define PG8_STAGE_A(bufoff, gbase, v0, v1) do { const char* _gb = uptr((const char*)(gbase) + ((!GATHER && ((bufoff) / HTB) % 2 == 1) ? hstepA : 0)); const unsigned _ld = (unsigned)__builtin_amdgcn_readfirstlane((int)(lds0 + (bufoff) + ldsw)); \
        glds16(_gb, (v0), _ld); glds16(_gb, (v1), _ld + 8192u); } while (0)
#define PG8_LDA(dst, b, h) do { if (FP8) { _Pragma("unroll") for (int m = 0; m < 4; ++m) dst##8[m] = fp8cat(*(const LAS bf16x8*)(lds + PG8_SA(b, h) + aoff + m * 2048), *(const LAS bf16x8*)(lds + PG8_SA(b, h) + aoff + m * 2048 + 1024)); } \
        else { _Pragma("unroll") for (int m = 0; m < 4; ++m) _Pragma("unroll") for (int k = 0; k < 2; ++k) dst[m][k] = *(const LAS bf16x8*)(lds + PG8_SA(b, h) + aoff + m * 2048 + k * 1024); } } while (0)
#define PG8_LDB(dst, b, h) do { if (FP8) { _Pragma("unroll") for (int n = 0; n < 2; ++n) dst##8[n] = fp8cat(*(const LAS bf16x8*)(lds + PG8_SB(b, h) + boff + n * 2048), *(const LAS bf16x8*)(lds + PG8_SB(b, h) + boff + n * 2048 + 1024)); } \
        else { _Pragma("unroll") for (int n = 0; n < 2; ++n) _Pragma("unroll") for (int k = 0; k < 2; ++k) dst[n][k] = *(const LAS bf16x8*)(lds + PG8_SB(b, h) + boff + n * 2048 + k * 1024); } } while (0)
#define PG8_MMA(ai, bj, At, Bt, Z) do { __builtin_amdgcn_s_setprio(1); \
        if (Z) {        \
            if (FP8) { _Pragma("unroll") for (int m = 0; m < 4; ++m) _Pragma("unroll") for (int n = 0; n < 2; ++n) \
                asm volatile("v_mfma_scale_f32_16x16x128_f8f6f4 %0, %1, %2, 0, %3, %3 op_sel_hi:[0,0,0]" : "=&v"(acc[ai][bj][m][n]) : "v"(Bt##8[n]), "v"(At##8[m]), "v"(sc8)); } \
            else { _Pragma("unroll") for (int m = 0; m < 4; ++m) _Pragma("unroll") for (int n = 0; n < 2; ++n) { \
                acc[ai][bj][m][n] = __builtin_amdgcn_mfma_f32_16x16x32_bf16(Bt[n][0], At[m][0], (f32x4){0.f, 0.f, 0.f, 0.f}, 0, 0, 0); acc[ai][bj][m][n] = __builtin_amdgcn_mfma_f32_16x16x32_bf16(Bt[n][1], At[m][1], acc[ai][bj][m][n], 0, 0, 0); } } \
        } else if (FP8) { _Pragma("unroll") for (int m = 0; m < 4; ++m) _Pragma("unroll") for (int n = 0; n < 2; ++n) \
            asm volatile("v_mfma_scale_f32_16x16x128_f8f6f4 %0, %1, %2, %0, %3, %3 op_sel_hi:[0,0,0]" : "+v"(acc[ai][bj][m][n]) : "v"(Bt##8[n]), "v"(At##8[m]), "v"(sc8)); } \
        else { _Pragma("unroll") for (int m = 0; m < 4; ++m) _Pragma("unroll") for (int n = 0; n < 2; ++n) _Pragma("unroll") for (int k = 0; k < 2; ++k) \
            acc[ai][bj][m][n] = __builtin_amdgcn_mfma_f32_16x16x32_bf16(Bt[n][k], At[m][k], acc[ai][bj][m][n], 0, 0, 0); } __builtin_amdgcn_s_setprio(0); } while (0)
#define PG8_MMA_THIN(ai, bj, At, Bt, Z) do { if ((ai) == 0 && wr == 0) { _Pragma("unroll") for (int n = 0; n < 2; ++n) _Pragma("unroll") for (int k = 0; k < 2; ++k) \
        acc[0][bj][0][n] = __builtin_amdgcn_mfma_f32_16x16x32_bf16(Bt[n][k], At[0][k], acc[0][bj][0][n], 0, 0, 0); } } while (0)
#define PG8_WAIT_V(n) asm volatile("s_waitcnt vmcnt(" #n ")" ::: "memory")
#define PG8_WAIT_L(n) asm volatile("s_waitcnt lgkmcnt(" #n ")" ::: "memory")
#define PG8_BAR __builtin_amdgcn_s_barrier()
#define PG8_SCHED __builtin_amdgcn_sched_barrier(0)
#define PG8_GOFF(v, u) do { if (GATHER) { _Pragma("unroll") for (int _h = 0; _h < 2; ++_h) _Pragma("unroll") for (int _i = 0; _i < 2; ++_i) \
        v[_h][_i] = (unsigned)(S.arow(u, _h * HALF + sR[_i]) * g.lda + sC[_i]) * 2u; } } while (0)
#define PG8_TBODY(MMA_, ZF) { \
            const bool last = (t == nt - 2); constexpr bool zf = ZF; \
            const char* a1 = cA + (size_t)(t + 1) * kstep; \
            const char* a2 = last ? nA : cA + (size_t)(t + 2) * kstep; const char* b2 = last ? nB : cB + (size_t)(t + 2) * kstep; \
            const char* a3 = a2 + kstep; const char* b3 = b2 + kstep; \
            const unsigned x00 = (GATHER && last) ? vN[0][0] : vC[0][0], x01 = (GATHER && last) ? vN[0][1] : vC[0][1], x10 = (GATHER && last) ? vN[1][0] : vC[1][0], x11 = (GATHER && last) ? vN[1][1] : vC[1][1]; \
            PG8_LDB(B0, 0, 0); PG8_LDB(B1, 0, 1); PG8_SCHED; PG8_LDA(At, 0, 0); PG8_STAGE_A(PG8_SA(1, 1), a1, vC[1][0], vC[1][1]); \
            PG8_WAIT_V(8); PG8_WAIT_L(0); PG8_BAR; MMA_(0, 0, At, B0, zf); MMA_(0, 1, At, B1, zf); PG8_BAR; PG8_SCHED; \
            PG8_LDA(At, 0, 1); PG8_STAGE(PG8_SB(0, 0), b2, voffB); PG8_STAGE(PG8_SB(0, 1), b2 + hstepB, voffB); PG8_STAGE_A(PG8_SA(0, 0), a2, x00, x01); \
            PG8_WAIT_V(8); PG8_WAIT_L(0); PG8_BAR; MMA_(1, 0, At, B0, zf); MMA_(1, 1, At, B1, zf); PG8_BAR; PG8_SCHED; \
            PG8_LDB(B0, 1, 0); PG8_LDB(B1, 1, 1); PG8_SCHED; PG8_LDA(At, 1, 0); PG8_STAGE_A(PG8_SA(0, 1), a2, x10, x11); \
            PG8_WAIT_V(8); PG8_WAIT_L(0); PG8_BAR; MMA_(0, 0, At, B0, false); MMA_(0, 1, At, B1, false); PG8_BAR; PG8_SCHED; \
            PG8_LDA(At, 1, 1); PG8_STAGE(PG8_SB(1, 0), b3, voffB); PG8_STAGE(PG8_SB(1, 1), b3 + hstepB, voffB); PG8_STAGE_A(PG8_SA(1, 0), a3, x00, x01); \
            PG8_WAIT_V(8); PG8_WAIT_L(0); PG8_BAR; MMA_(1, 0, At, B0, false); MMA_(1, 1, At, B1, false); PG8_BAR; PG8_SCHED; \
        }
#define PG8_UNI(u) do { u.pm = __builtin_amdgcn_readfirstlane(u.pm); u.pn = __builtin_amdgcn_readfirstlane(u.pn); u.aoff = __builtin_amdgcn_readfirstlane(u.aoff); u.boff = __builtin_amdgcn_readfirstlane(u.boff); \
        u.grp = __builtin_amdgcn_readfirstlane(u.grp); u.prow = __builtin_amdgcn_readfirstlane(u.prow); } while (0)
    Unit cur, nxt; int ui = 0; float rcache[8]; int rcache_pm = -1; (void)rcache; (void)rcache_pm;
    if (!S.next(0, cur)) return;
    PG8_UNI(cur);
    constexpr bool ZC = FP8 && !Sched::THIN_META;
    f32x4 acc[2][2][4][2];
    if (!ZC)
#pragma unroll
    for (int a = 0; a < 2; ++a)
#pragma unroll
        for (int b = 0; b < 2; ++b)
#pragma unroll
            for (int m = 0; m < 4; ++m)
#pragma unroll
                for (int n = 0; n < 2; ++n) acc[a][b][m][n] = (f32x4){0.f, 0.f, 0.f, 0.f};
    const int sc8 = 0x7F7F7F7F;
    bf16x8 At[4][2], B0[2][2], B1[2][2]; v8i At8[4], B08[2], B18[2];
    const char* cA = (const char*)g.A + (GATHER ? (size_t)0 : (size_t)cur.pm * tstepA) + cur.aoff; const char* cB = (const char*)g.Bt + (size_t)cur.pn * tstepB + cur.boff;
    PG8_GOFF(vC, cur);
    PG8_STAGE(PG8_SB(0, 0), cB, voffB); PG8_STAGE(PG8_SB(0, 1), cB + hstepB, voffB); PG8_STAGE_A(PG8_SA(0, 0), cA, vC[0][0], vC[0][1]); PG8_STAGE_A(PG8_SA(0, 1), cA, vC[1][0], vC[1][1]);
    if (wr == 1) PG8_BAR;
    PG8_WAIT_V(2); PG8_BAR;
    PG8_STAGE(PG8_SB(1, 0), cB + kstep, voffB); PG8_STAGE_A(PG8_SA(1, 0), cA + kstep, vC[0][0], vC[0][1]); PG8_STAGE(PG8_SB(1, 1), cB + hstepB + kstep, voffB);
    PG8_WAIT_V(6); PG8_BAR;
    for (;;) {
        const bool has_next = S.next(ui + 1, nxt);
        PG8_UNI(nxt);
        const char* nA = has_next ? (const char*)g.A + (GATHER ? (size_t)0 : (size_t)nxt.pm * tstepA) + nxt.aoff : cA; const char* nB = has_next ? (const char*)g.Bt + (size_t)nxt.pn * tstepB + nxt.boff : cB;
        if (GATHER) { if (has_next) { PG8_GOFF(vN, nxt); } else {
#pragma unroll
            for (int _h = 0; _h < 2; ++_h)
#pragma unroll
                for (int _i = 0; _i < 2; ++_i) vN[_h][_i] = vC[_h][_i]; } }
        const bool thin = Sched::THIN_META && cur.pm == MR / 256;
        if (thin) { _Pragma("unroll 1") for (int t = 0; t < nt; t += 2) PG8_TBODY(PG8_MMA_THIN, false) }
        else if (ZC) { { const int t = 0; PG8_TBODY(PG8_MMA, true) }
            _Pragma("unroll 1") for (int t = 2; t < nt; t += 2) PG8_TBODY(PG8_MMA, false) }
        else { _Pragma("unroll 1") for (int t = 0; t < nt; t += 2) PG8_TBODY(PG8_MMA, false) }
        if (FP8) asm volatile("s_nop 15\n\ts_nop 15" ::: "memory");
        if (wr == 0) PG8_BAR;
        { int ln_; asm volatile("v_mbcnt_lo_u32_b32 %0, -1, 0\n\tv_mbcnt_hi_u32_b32 %0, -1, %0" : "=v"(ln_)); if constexpr (epi_caches_rows<Epi>::value) E(acc, cur, S, wr, wc, ln_ & 15, ln_ >> 4, rcache, rcache_pm); else E(acc, cur, S, wr, wc, ln_ & 15, ln_ >> 4); }
        if (!has_next) break;
        if (!ZC)
#pragma unroll
        for (int a = 0; a < 2; ++a)
#pragma unroll
            for (int b = 0; b < 2; ++b)
#pragma unroll
                for (int m = 0; m < 4; ++m)
#pragma unroll
                    for (int n = 0; n < 2; ++n) acc[a][b][m][n] = (f32x4){0.f, 0.f, 0.f, 0.f};
        cur = nxt; cA = nA; cB = nB; ++ui;
#pragma unroll
        for (int _h = 0; _h < 2; ++_h)
#pragma unroll
            for (int _i = 0; _i < 2; ++_i) vC[_h][_i] = vN[_h][_i];
        if (wr == 1) PG8_BAR;
    }
    PG8_WAIT_V(0);
    PG8_BAR;
#undef PG8_SA
#undef PG8_SB
#undef PG8_STAGE
#undef PG8_STAGE_A
#undef PG8_LDA
#undef PG8_LDB
#undef PG8_MMA
#undef PG8_MMA_THIN
#undef PG8_TBODY
#undef PG8_WAIT_V
#undef PG8_WAIT_L
#undef PG8_BAR
#undef PG8_SCHED
#undef PG8_GOFF
#undef PG8_UNI
}
}

#define XB_TMO      128
#define XB_XCNT(j)  (256  + 64 * (j))
#define XB_XSUB(j)  (1280 + 64 * (j))
#define XB_XGEN(j)  (2304 + 64 * (j))
#define XB_TOP      3328
#define XB_TOPGEN   3392
#define XCD_BAR_WORDS 3456
#define XB_SPIN_CAP (1u << 18)
__device__ __forceinline__ unsigned xb_ld(unsigned* p)              { return __hip_atomic_load(p, __ATOMIC_RELAXED, __HIP_MEMORY_SCOPE_AGENT); }
__device__ __forceinline__ unsigned xb_add(unsigned* p, unsigned v) { return __hip_atomic_fetch_add(p, v, __ATOMIC_RELAXED, __HIP_MEMORY_SCOPE_AGENT); }
__device__ __forceinline__ unsigned xb_xcc_id() { return (unsigned)__builtin_amdgcn_s_getreg((3 << 11) | 20) & 0xFu; }
#define XB_SPIN(cond, bar) do { unsigned _sp = 0; while (cond) { __builtin_amdgcn_s_sleep(1); \
    if ((++_sp & 255u) == 0u) { if (xb_ld(&(bar)[XB_TMO])) break; if (_sp > XB_SPIN_CAP) { atomicAdd(&(bar)[XB_TMO], 1u); break; } } } } while (0)
struct XcdBarrier { unsigned* bar; unsigned x; volatile LAS unsigned* st; };
__device__ __forceinline__ bool xb_is_t0(int wave_s) { return wave_s == 0 && __builtin_amdgcn_mbcnt_hi(~0u, __builtin_amdgcn_mbcnt_lo(~0u, 0u)) == 0u; }
__device__ __forceinline__ XcdBarrier xcd_barrier_post(unsigned* bar, volatile LAS unsigned* st, int wave_s) {
    XcdBarrier b; b.bar = bar; b.x = xb_xcc_id(); b.st = st;
    if (xb_is_t0(wave_s)) (void)xb_add(&bar[XB_XCNT(b.x)], 1u);
    return b;
}
__device__ __forceinline__ void xcd_barrier_complete(unsigned* bar, unsigned x, unsigned& nloc, unsigned& nx) {
    const unsigned G = gridDim.x * gridDim.y * gridDim.z;
    unsigned sum, cnt, mine, sp = 0u;
    for (;;) {
        sum = 0u; cnt = 0u; mine = 0u;
#pragma unroll
        for (unsigned j = 0; j < 16; ++j) { const unsigned c = xb_ld(&bar[XB_XCNT(j)]); sum += c; cnt += (c > 0u) ? 1u : 0u; mine = (j == x) ? c : mine; }
        if (sum == G) break;
        __builtin_amdgcn_s_sleep(1);
        if ((++sp & 255u) == 0u) { if (xb_ld(&bar[XB_TMO])) break; if (sp > XB_SPIN_CAP) { atomicAdd(&bar[XB_TMO], 1u); break; } }
    }
    nloc = mine > 0u ? mine : 1u; nx = cnt > 0u ? cnt : 1u;
}
__device__ __forceinline__ void xcd_barrier(const XcdBarrier& b, int wave_s) {
    asm volatile("s_waitcnt vmcnt(0)" ::: "memory");
    __syncthreads();
    if (xb_is_t0(wave_s)) {
        unsigned* bar = b.bar; asm volatile("" : "+s"(bar));
        __builtin_amdgcn_s_waitcnt(0);
        unsigned nloc = b.st[0], nx = b.st[1];
        if (nloc == 0u) { xcd_barrier_complete(bar, b.x, nloc, nx); b.st[0] = nloc; b.st[1] = nx; }
        const unsigned old = xb_add(&bar[XB_XSUB(b.x)], 1u);
        const unsigned gen = old / nloc;
        if (old + 1u == (gen + 1u) * nloc) {
            __builtin_amdgcn_fence(__ATOMIC_RELEASE, "agent");
            asm volatile("s_waitcnt vmcnt(0)" ::: "memory");
            const unsigned og = xb_add(&bar[XB_TOP], 1u);
            const unsigned tg = og / nx;
            if (og + 1u == (tg + 1u) * nx) xb_add(&bar[XB_TOPGEN], 1u);
            else XB_SPIN(xb_ld(&bar[XB_TOPGEN]) == tg, bar);
            __builtin_amdgcn_fence(__ATOMIC_ACQUIRE, "agent");
            xb_add(&bar[XB_XGEN(b.x)], 1u);
            asm volatile("s_waitcnt vmcnt(0)" ::: "memory");
        } else {
            XB_SPIN(xb_ld(&bar[XB_XGEN(b.x)]) == gen, bar);
            __builtin_amdgcn_fence(__ATOMIC_ACQUIRE, "agent");
            asm volatile("s_waitcnt vmcnt(0)" ::: "memory");
        }
    }
    __syncthreads();
}

#define CAS __attribute__((address_space(4)))
struct Frame {
    LAS unsigned char* lds;
    volatile LAS unsigned* MISC;
    gu32* ctl;
    int tid, lane, wave, G, vcu;
    const CAS unsigned char* ka;
    unsigned char* ws;
    float* out;
    bf16_t* hb;
    __device__ __forceinline__ const void* in(int i) const { return ((const void* const CAS*)ka)[i]; }
};
struct Args { const void* in[29]; float* out; unsigned char* ws; int pad0, pad1; };
__device__ __forceinline__ Frame mkframe(unsigned char* lds_raw, int wave_s) {
    Frame F; int lane_; asm volatile("v_mbcnt_lo_u32_b32 %0, -1, 0\n\tv_mbcnt_hi_u32_b32 %0, -1, %0" : "=v"(lane_));
    int tid = wave_s * 64 + lane_;
    const CAS unsigned char* ka = (const CAS unsigned char*)__builtin_amdgcn_kernarg_segment_ptr(); asm volatile("" : "+s"(ka));
    F.ka = ka; F.lds = (LAS unsigned char*)lds_raw; F.MISC = (volatile LAS unsigned*)(F.lds + MISC_OFF);
    F.tid = tid; F.lane = tid & 63; F.wave = __builtin_amdgcn_readfirstlane(tid >> 6);
    int G = gridDim.x; asm volatile("" : "+s"(G)); F.G = G; { const int bx = blockIdx.x; F.vcu = (G % 8 == 0) ? (bx % 8) * (G / 8) + bx / 8 : bx; }
    F.out = *(float* const CAS*)(ka + 232); F.ws = *(unsigned char* const CAS*)(ka + 240);
    F.hb = (bf16_t*)(F.ws + WS_HB); F.ctl = (gu32*)(F.ws + WS_CTL);
    return F;
}
enum { I_X = 0, I_POS, I_META, I_NORM_MIX_G, I_W_IN, I_Q_NORM_G, I_W_UQ, I_KV_NORM_G, I_W_UKV, I_Q_HEAD_G, I_K_HEAD_G, I_CONV_W, I_CONV_B, I_W_A, I_B_A, I_W_I, I_B_I, I_LAMBDA,
       I_ATT_G, I_RNN_G, I_W_OUT, I_NORM_FFN_G, I_FFN_GATE, I_FFN_UP, I_FFN_DOWN, I_ROUTER, I_MOE_GATE, I_MOE_UP, I_MOE_DOWN };


__device__ __forceinline__ void tr_item(const float* W, int ldw, int k0, int n0, bf16_t* WT, int ldk, int drow0, const float* gain, LAS float* scr, int lane, unsigned char* W8 = nullptr, bool only8 = false) {
    { const int lr = lane >> 3, lc = (lane & 7) * 4; f32x4 v[8]; float gn[8];
#pragma unroll
      for (int i = 0; i < 8; ++i) { const int kk = 8 * i + lr; v[i] = *(const GAS f32x4*)(W + (size_t)(k0 + kk) * ldw + n0 + lc); gn[i] = gain ? gain[k0 + kk] : 1.f; }
#pragma unroll
      for (int i = 0; i < 8; ++i) { LAS float* d = scr + (8 * i + lr) * 33 + lc; d[0] = v[i][0] * gn[i]; d[1] = v[i][1] * gn[i]; d[2] = v[i][2] * gn[i]; d[3] = v[i][3] * gn[i]; } }
    LDS_WAIT(); asm volatile("" ::: "memory");
    const int c = lane & 7;
#pragma unroll
    for (int j = 0; j < 4; ++j) { const int n = (lane >> 3) + 8 * j; const LAS float* s = scr + (8 * c) * 33 + n;
        u32x4 o; o.x = pk2(s[0 * 33], s[1 * 33]); o.y = pk2(s[2 * 33], s[3 * 33]); o.z = pk2(s[4 * 33], s[5 * 33]); o.w = pk2(s[6 * 33], s[7 * 33]);
        if (!only8) *(GAS u32x4*)(WT + (size_t)(drow0 + n) * ldk + k0 + 8 * c) = o;
        if (W8) *(GAS u32x2*)(W8 + (size_t)(drow0 + n) * ldk + k0 + 8 * c) = (u32x2){pk4_fp8(64.f * s[0 * 33], 64.f * s[1 * 33], 64.f * s[2 * 33], 64.f * s[3 * 33]), pk4_fp8(64.f * s[4 * 33], 64.f * s[5 * 33], 64.f * s[6 * 33], 64.f * s[7 * 33])}; }
    LDS_WAIT(); asm volatile("" ::: "memory");
}
__device__ __forceinline__ int tr_map(int mode, int n) {
    if (mode == 0) return n;
    if (mode == 1) return n < 384 ? n : (n < 640 ? n + 128 : (n < 672 ? n - 256 : n + 96));
    if (mode == 4) { const int h = n >> 7, d = n & 127; return d < 64 ? 256 * (h >> 2) + 128 * (d >> 5) + 32 * (h & 3) + (d & 31) : 512 + 64 * h + (d - 64); }
    return 256 * (n >> 7) + (n & 127) + (mode == 3 ? 128 : 0);
}
__device__ __forceinline__ void tr_job(const float* W, int K, int N, bf16_t* WT, const float* gain, int mode, int item, LAS float* scr, int lane, unsigned char* W8 = nullptr, bool only8 = false, int ldk8 = 0) {
    const int nblk = N / 32, kb = item / nblk, nb = item % nblk;
    tr_item(W, N, 64 * kb, 32 * nb, WT, ldk8 ? ldk8 : K, tr_map(mode, 32 * nb), gain, scr, lane, W8, only8);
}
constexpr int IT_IN = (DM / 64) * (DIN / 32), IT_UQ = (QL / 64) * (768 / 32), IT_UKV = (KVL / 64) * (1024 / 32), IT_OUT = (DM / 64) * (DM / 32), IT_MIX = IT_IN + IT_UQ + IT_UKV + IT_OUT;
constexpr int IT_DG = (DM / 64) * (DFF / 32), IT_DD = (DFF / 64) * (DM / 32), IT_DENSE = 2 * IT_DG + IT_DD;
constexpr int IT_MG = (DM / 64) * (DFE / 32), IT_MD = (DFE / 64) * (DM / 32), IT_EXP = 2 * IT_MG + IT_MD;
constexpr int JIT_SPLIT = 11264;

__device__ __forceinline__ void conv_mixer_dense_weights(const Frame& F) {
    LAS float* scr = (LAS float*)(F.lds + F.wave * 16384);
    const int gw = F.vcu * NWAVES + F.wave, NGW = F.G * NWAVES;
    unsigned char* wb = F.ws + WS_W;
    for (int it = gw; it < 4 * IT_MIX + 2 * IT_DENSE; it += NGW) {
        if (it < 4 * IT_MIX) {
            const int l = it / IT_MIX; int r = it % IT_MIX; unsigned char* lb = wb + (size_t)l * W_LAYER;
            if (r < IT_IN) { tr_job((const float*)F.in(I_W_IN) + (size_t)l * DM * DIN, DM, DIN, (bf16_t*)(lb + W_IN), (const float*)F.in(I_NORM_MIX_G) + l * DM, 1, r, scr, F.lane); continue; } r -= IT_IN;
            if (r < IT_UQ) { tr_job((const float*)F.in(I_W_UQ) + (size_t)l * QL * 768, QL, 768, (bf16_t*)(lb + W_UQ), (const float*)F.in(I_Q_NORM_G) + l * QL, 0, r, scr, F.lane); continue; } r -= IT_UQ;
            if (r < IT_UKV) { tr_job((const float*)F.in(I_W_UKV) + (size_t)l * KVL * 1024, KVL, 1024, (bf16_t*)(lb + W_UKV), (const float*)F.in(I_KV_NORM_G) + l * KVL, 4, r, scr, F.lane); continue; } r -= IT_UKV;
            {
                const int nblk = DM / 32, kb = r / nblk, nb = r % nblk; const float* gain = kb < 8 ? (const float*)F.in(I_ATT_G) + l * 512 : (const float*)F.in(I_RNN_G) + l * 512 - 512;
                tr_item((const float*)F.in(I_W_OUT) + (size_t)l * DM * DM, DM, 64 * kb, 32 * nb, (bf16_t*)(lb + W_OUT), DM, 32 * nb, gain, scr, F.lane); }
        } else {
            int r = it - 4 * IT_MIX; const int j = r / IT_DENSE; r %= IT_DENSE; unsigned char* db = wb + W_DENSE + (size_t)j * W_DENSE_STRIDE; const float* gain = (const float*)F.in(I_NORM_FFN_G) + (2 * j) * DM;
            if (r < IT_DG) { tr_job((const float*)F.in(I_FFN_GATE) + (size_t)j * DM * DFF, DM, DFF, (bf16_t*)db, gain, 2, r, scr, F.lane, F.ws + WS_W8 + (size_t)j * SZ_W8); continue; } r -= IT_DG;
            if (r < IT_DG) { tr_job((const float*)F.in(I_FFN_UP) + (size_t)j * DM * DFF, DM, DFF, (bf16_t*)db, gain, 3, r, scr, F.lane, F.ws + WS_W8 + (size_t)j * SZ_W8); continue; } r -= IT_DG;
            tr_job((const float*)F.in(I_FFN_DOWN) + (size_t)j * DFF * DM, DFF, DM, (bf16_t*)(db + SZ_UP), nullptr, 0, r, scr, F.lane, wb + W_MOE + NE * SZ_MUP8 + (size_t)j * SZ_DN8);
        }
    }
}
__device__ __forceinline__ void conv_moe_weights(const Frame& F, int j, int it0 = 0, int it1 = NE * IT_EXP, int wgr = -1, int nwg = 0, bool pad = true) {
    LAS float* scr = (LAS float*)(F.lds + F.wave * 16384);
    const int gw = (wgr < 0 ? F.vcu : wgr) * NWAVES + F.wave, NGW = (wgr < 0 ? F.G : nwg) * NWAVES;
    unsigned char* wb = F.ws + WS_W; const float* gain = (const float*)F.in(I_NORM_FFN_G) + (2 * j + 1) * DM;
    for (int it = it0 + gw; it < it1; it += NGW) {
        const int e = it / IT_EXP; int r = it % IT_EXP; const size_t eo = (size_t)(j * NE + e);
        if (r < IT_MG) { tr_job((const float*)F.in(I_MOE_GATE) + eo * DM * DFE, DM, DFE, nullptr, gain, 2, r, scr, F.lane, wb + W_MOE + (size_t)e * SZ_MUP8, true); continue; } r -= IT_MG;
        if (r < IT_MG) { tr_job((const float*)F.in(I_MOE_UP) + eo * DM * DFE, DM, DFE, nullptr, gain, 3, r, scr, F.lane, wb + W_MOE + (size_t)e * SZ_MUP8, true); continue; } r -= IT_MG;
        tr_job((const float*)F.in(I_MOE_DOWN) + eo * DFE * DM, DFE, DM, nullptr, nullptr, 0, r, scr, F.lane, wb + W_MOE_DN + (size_t)e * SZ_MDN8, true, DFE8);
    }
    if (pad) for (int i = F.vcu * NTHREADS + F.tid; i < NE * DM * 8; i += F.G * NTHREADS) *(GAS u32x4*)(wb + W_MOE_DN + (size_t)(i >> 3) * DFE8 + DFE + (i & 7) * 16) = (u32x4){0u, 0u, 0u, 0u};
}
__device__ __forceinline__ void prologue_misc(const Frame& F) {
    const int gt = F.vcu * NTHREADS + F.tid, NGT = F.G * NTHREADS;
    unsigned char* wb = F.ws + WS_W;
    for (int i = gt; i < 4 * 96 * (DM / 8); i += NGT) { const int l = i / (96 * (DM / 8)), r = i % (96 * (DM / 8)); *(GAS u32x4*)(wb + (size_t)l * W_LAYER + W_IN + ((size_t)(416 + r / (DM / 8)) * DM + (r % (DM / 8)) * 8) * 2) = (u32x4){0u, 0u, 0u, 0u}; }
    for (int i0 = gt; i0 < 4 * 4 * 256 * 256; i0 += 8 * NGT) {
        float vv[8];
#pragma unroll
        for (int q = 0; q < 8; ++q) { const int i = i0 + q * NGT; vv[q] = 0.f; if (i < 4 * 4 * 256 * 256) {
            const int kk = i & 255, rr = (i >> 8) & 255, j = (i >> 16) & 3, l = i >> 18;
            const int ch = 128 * j + (rr & 127), blk = ch >> 6, d = ch & 63, cin = 256 * (j >> 1) + kk, blk_in = cin >> 6, c = cin & 63;
            const float* Wsrc = (const float*)F.in(rr < 128 ? I_W_A : I_W_I) + (size_t)l * 8 * 64 * 64;
            if (blk_in == blk) vv[q] = Wsrc[(blk * 64 + c) * 64 + d]; } }
#pragma unroll
        for (int q = 0; q < 8; ++q) { const int i = i0 + q * NGT; if (i < 4 * 4 * 256 * 256) {
            const int kk = i & 255, rr = (i >> 8) & 255, j = (i >> 16) & 3, l = i >> 18;
            ((bf16_t*)(wb + (size_t)l * W_LAYER + W_G))[((size_t)j * 256 + rr) * 256 + kk] = (bf16_t)f2bf(vv[q]); } }
    }
    float* rope = (float*)(F.ws + WS_ROPE);
    for (int i = gt; i < MP * 16; i += NGT) {
        const int row = i >> 4, k = i & 15; int pos = 0;
        if (row < MR) pos = ((const int*)F.in(I_POS))[row] + NMETA; else if (row < MVALID) pos = row - MR;
        const double ang = (double)pos * exp(-(double)k / 16.0 * 9.210340371976184);
        double s, c; sincos(ang, &s, &c);
        rope[(size_t)row * 32 + k] = (float)c; rope[(size_t)row * 32 + 16 + k] = (float)s;
    }
}
__device__ __forceinline__ void phase_x_to_hb(const Frame& F) {
    const int gw = F.vcu * NWAVES + F.wave, NGW = F.G * NWAVES; float* ssq = (float*)(F.ws + WS_SSQ1);
    for (int row0 = 4 * gw; row0 < MP; row0 += 4 * NGW) {
        f32x4 v[4][4];
#pragma unroll
        for (int r = 0; r < 4; ++r) { const int row = row0 + r;
            if (row < MVALID) { const float* xr = row < MR ? (const float*)F.in(I_X) + (size_t)row * DM : (const float*)F.in(I_META) + (size_t)(row - MR) * DM;
#pragma unroll
                for (int j = 0; j < 4; ++j) v[r][j] = ((const GAS f32x4*)xr)[F.lane + 64 * j]; }
            else {
#pragma unroll
                for (int j = 0; j < 4; ++j) v[r][j] = (f32x4){0.f, 0.f, 0.f, 0.f}; } }
#pragma unroll
        for (int r = 0; r < 4; ++r) { const int row = row0 + r; float s = 0.f;
#pragma unroll
            for (int j = 0; j < 4; ++j) s += (v[r][j].x * v[r][j].x + v[r][j].y * v[r][j].y) + (v[r][j].z * v[r][j].z + v[r][j].w * v[r][j].w);
            s = wave_sum(s, F.lane);
            GAS u32x2* o = (GAS u32x2*)(F.hb + (size_t)row * DM);
#pragma unroll
            for (int j = 0; j < 4; ++j) o[F.lane + 64 * j] = (u32x2){pk2(v[r][j].x, v[r][j].y), pk2(v[r][j].z, v[r][j].w)};
            if (F.lane < 16) ssq[(size_t)row * 16 + F.lane] = F.lane == 0 ? s : 0.f; }
    }
}

__device__ __forceinline__ void phase_e1(const Frame& F, int l) {
    const int gw = F.vcu * NWAVES + F.wave, NGW = F.G * NWAVES;
    const bf16_t* XR = (const bf16_t*)(F.ws + T_XR); bf16_t* XC = (bf16_t*)(F.ws + T_XC);
    const float* cw = (const float*)F.in(I_CONV_W) + (size_t)l * 4 * DR; const float* cb = (const float*)F.in(I_CONV_B) + (size_t)l * DR;
    const int ch0 = F.lane * 8; float wt[4][8], bs[8];
    { const f32x4 b0 = *(const GAS f32x4*)(cb + ch0), b1 = *(const GAS f32x4*)(cb + ch0 + 4); bs[0] = b0.x; bs[1] = b0.y; bs[2] = b0.z; bs[3] = b0.w; bs[4] = b1.x; bs[5] = b1.y; bs[6] = b1.z; bs[7] = b1.w; }
#pragma unroll
    for (int j = 0; j < 4; ++j) { const f32x4 w0 = *(const GAS f32x4*)(cw + j * DR + ch0), w1 = *(const GAS f32x4*)(cw + j * DR + ch0 + 4);
        wt[j][0] = w0.x; wt[j][1] = w0.y; wt[j][2] = w0.z; wt[j][3] = w0.w; wt[j][4] = w1.x; wt[j][5] = w1.y; wt[j][6] = w1.z; wt[j][7] = w1.w; }
    for (int g = gw; g < MP / 4; g += NGW) {
        const int row0 = 4 * g;
        const int t0 = row0 < MR ? NMETA + (row0 & (SEQ - 1)) : row0 - MR; const int rb = row0 < MR ? (row0 & ~(SEQ - 1)) : 0;
        u32x4 x[7];
#pragma unroll
        for (int k = 0; k < 7; ++k) { const int tt = t0 - 3 + k; x[k] = (u32x4){0u, 0u, 0u, 0u};
            if (row0 < MVALID && tt >= 0) { const int srow = tt < NMETA ? MR + tt : rb + (tt - NMETA); x[k] = *(const GAS u32x4*)(XR + (size_t)srow * 512 + ch0); } }
#pragma unroll
        for (int r = 0; r < 4; ++r) { float acc[8];
#pragma unroll
            for (int e = 0; e < 8; ++e) acc[e] = row0 < MVALID ? bs[e] : 0.f;
#pragma unroll
            for (int j = 0; j < 4; ++j) { const u32x4 v = x[r + j];
                acc[0] += bflo(v.x) * wt[j][0]; acc[1] += bfhi(v.x) * wt[j][1]; acc[2] += bflo(v.y) * wt[j][2]; acc[3] += bfhi(v.y) * wt[j][3];
                acc[4] += bflo(v.z) * wt[j][4]; acc[5] += bfhi(v.z) * wt[j][5]; acc[6] += bflo(v.w) * wt[j][6]; acc[7] += bfhi(v.w) * wt[j][7]; }
            *(GAS u32x4*)(XC + (size_t)(row0 + r) * 512 + ch0) = (u32x4){pk2(acc[0], acc[1]), pk2(acc[2], acc[3]), pk2(acc[4], acc[5]), pk2(acc[6], acc[7])}; }
    }
}
__device__ __forceinline__ void phase_route(const Frame& F, int jm) {
    const int gw = F.vcu * NWAVES + F.wave, NGW = F.G * NWAVES, lane = F.lane;
    int* list = (int*)(F.ws + WS_LIST); f32x2* wlist = (f32x2*)(F.ws + WS_WLIST);
    const float* g = (const float*)F.in(I_NORM_FFN_G) + (2 * jm + 1) * DM; const float* wr = (const float*)F.in(I_ROUTER) + (size_t)jm * DM * NE;
    LAS f32x4* T = (LAS f32x4*)F.lds; LAS unsigned* rec = (LAS unsigned*)(F.lds + 32768); LAS unsigned* lcnt = (LAS unsigned*)(F.lds + 32768 + 17 * NWAVES * 32); LAS unsigned* gbase = lcnt + 16;
    if (F.tid < 16) lcnt[F.tid] = 0u;
    int nrec = 0;
    for (int idx = F.tid; idx < 2 * 16 * 64; idx += NTHREADS) { const int ln = idx & 63, i = (idx >> 6) & 15, half = idx >> 10, k = 512 * (i >> 3) + 8 * ln + (i & 7);
        const f32x4 w = *(const GAS f32x4*)(wr + (size_t)k * 8 + 4 * half); T[idx] = w * g[k]; }
    __syncthreads();
    u32x4 cur[2] = {(u32x4){0u, 0u, 0u, 0u}, (u32x4){0u, 0u, 0u, 0u}};
    if (gw < MVALID) { cur[0] = *(const GAS u32x4*)(F.hb + (size_t)gw * DM + 8 * lane); cur[1] = *(const GAS u32x4*)(F.hb + (size_t)gw * DM + 512 + 8 * lane); }
    for (int row = gw; row < MVALID; row += NGW) {
        float v[16]; float s = 0.f; u32x4 nxt[2] = {cur[0], cur[1]};
        if (row + NGW < MVALID) { nxt[0] = *(const GAS u32x4*)(F.hb + (size_t)(row + NGW) * DM + 8 * lane); nxt[1] = *(const GAS u32x4*)(F.hb + (size_t)(row + NGW) * DM + 512 + 8 * lane); }
#pragma unroll
        for (int j = 0; j < 2; ++j) { const u32x4 w = cur[j];
            v[8 * j] = bflo(w.x); v[8 * j + 1] = bfhi(w.x); v[8 * j + 2] = bflo(w.y); v[8 * j + 3] = bfhi(w.y); v[8 * j + 4] = bflo(w.z); v[8 * j + 5] = bfhi(w.z); v[8 * j + 6] = bflo(w.w); v[8 * j + 7] = bfhi(w.w); }
        f32x4 la = {0.f, 0.f, 0.f, 0.f}, lb = {0.f, 0.f, 0.f, 0.f};
#pragma unroll
        for (int i = 0; i < 16; ++i) { s += v[i] * v[i]; la += T[i * 64 + lane] * v[i]; lb += T[(16 + i) * 64 + lane] * v[i]; }
        const float rs = __builtin_amdgcn_rsqf(wave_sum(s, lane) * (1.f / DM) + EPS);
        f32x4 keep = (lane & 32) ? lb : la, give = (lane & 32) ? la : lb;
#pragma unroll
        for (int e = 0; e < 4; ++e) keep[e] += shfl_xor_(give[e], 32, lane);
        float k0 = (lane & 16) ? keep[2] : keep[0], k1 = (lane & 16) ? keep[3] : keep[1], g0 = (lane & 16) ? keep[0] : keep[2], g1 = (lane & 16) ? keep[1] : keep[3];
        k0 += shfl_xor_(g0, 16, lane); k1 += shfl_xor_(g1, 16, lane);
        float x = (lane & 8) ? k1 : k0; const float gx = (lane & 8) ? k0 : k1; x += shfl_xor_(gx, 8, lane);
        x += shfl_xor_(x, 4, lane); x += shfl_xor_(x, 2, lane); x += shfl_xor_(x, 1, lane);
        float lg[8];
#pragma unroll
        for (int e = 0; e < 8; ++e) lg[e] = __builtin_bit_cast(float, __builtin_amdgcn_readlane(__builtin_bit_cast(int, x), 8 * e)) * rs;
        int e0 = 0; float v0 = lg[0];
#pragma unroll
        for (int e = 1; e < 8; ++e) if (lg[e] > v0) { v0 = lg[e]; e0 = e; }
        int e1 = -1; float v1 = -3.0e38f;
#pragma unroll
        for (int e = 0; e < 8; ++e) if (e != e0 && lg[e] > v1) { v1 = lg[e]; e1 = e; }
        const float w1 = __builtin_amdgcn_rcpf(1.0f + __expf(v0 - v1)), w0 = 1.0f - w1;
        if (lane == 0) {
            const unsigned p0 = __hip_atomic_fetch_add(lcnt + e0, 1u, __ATOMIC_RELAXED, __HIP_MEMORY_SCOPE_WORKGROUP), p1 = __hip_atomic_fetch_add(lcnt + 8 + e1, 1u, __ATOMIC_RELAXED, __HIP_MEMORY_SCOPE_WORKGROUP);
            LAS unsigned* r = rec + (nrec * NWAVES + F.wave) * 8; r[0] = (unsigned)row; r[1] = (unsigned)e0 | ((unsigned)(8 + e1) << 8); r[2] = p0; r[3] = p1; r[4] = __builtin_bit_cast(unsigned, w0); r[5] = __builtin_bit_cast(unsigned, w1); r[6] = __builtin_bit_cast(unsigned, rs);
        }
        ++nrec; cur[0] = nxt[0]; cur[1] = nxt[1];
    }
    __syncthreads();
    if (F.tid < 16) gbase[F.tid] = __hip_atomic_fetch_add(F.ctl + CW_MOE + 64 * F.tid, lcnt[F.tid], RLX_AGENT);
    __syncthreads();
    for (int i = F.tid; i < 17 * NWAVES; i += NTHREADS) { const int n = i / NWAVES, w = i % NWAVES; const int row = (F.vcu * NWAVES + w) + n * NGW;
        if (row < MVALID) { const LAS unsigned* r = rec + i * 8; const unsigned g0 = r[1] & 255u, g1 = r[1] >> 8; const float rs = __builtin_bit_cast(float, r[6]);
            const size_t q0 = (size_t)g0 * MP + gbase[g0] + r[2], q1 = (size_t)g1 * MP + gbase[g1] + r[3];
            list[q0] = (int)r[0]; wlist[q0] = (f32x2){__builtin_bit_cast(float, r[4]), rs}; list[q1] = (int)r[0]; wlist[q1] = (f32x2){__builtin_bit_cast(float, r[5]), rs}; } }
    __syncthreads();
}
__device__ __forceinline__ void phase_moe_init(const Frame& F) {
    const int gt = F.vcu * NTHREADS + F.tid, NGT = F.G * NTHREADS;
    int* list = (int*)(F.ws + WS_LIST);
    for (int i = gt; i < 16 * MP / 4; i += NGT) ((GAS u32x4*)list)[i] = (u32x4){0xffffffffu, 0xffffffffu, 0xffffffffu, 0xffffffffu};
    if (gt < 16) __hip_atomic_store(F.ctl + CW_MOE + 64 * gt, 0u, RLX_AGENT);
}

struct GateC { float c8, ba, bi; };
__device__ __forceinline__ unsigned gate_ab(unsigned raw, float xc, const GateC& g) {
    const float r = sigmoidf_(bflo(raw) + g.ba), ig = sigmoidf_(bfhi(raw) + g.bi);
    const float la2 = g.c8 * r, a = __builtin_amdgcn_exp2f(la2), mult = __builtin_amdgcn_sqrtf(fmaxf(1.0f - a * a, 0.f));
    return f2bf(la2) | (f2bf(mult * ig * xc) << 16);
}
__device__ __forceinline__ GateC gate_consts(const Frame& F, int l, int c) {
    const float L = ((const float*)F.in(I_LAMBDA))[l * DR + c]; const float sp = (L > 15.f) ? __expf(-L) : log1pf(__expf(-L));
    GateC g; g.c8 = -8.0f * sp * 1.4426950408889634f; g.ba = ((const float*)F.in(I_B_A))[l * DR + c]; g.bi = ((const float*)F.in(I_B_I))[l * DR + c]; return g;
}
__device__ __forceinline__ void phase_scan1(const Frame& F, int l) {
    unsigned* AB = (unsigned*)((unsigned char*)F.out + D_AB); const bf16_t* XC = (const bf16_t*)(F.ws + T_XC); f32x2* SC = (f32x2*)(F.ws + WS_SCAN); const int c = F.tid;
    const GateC gc = gate_consts(F, l, c);
    for (int u = blockIdx.x; u < NB * SCAN_NCH; u += F.G) {
        const int b = u / SCAN_NCH, k = u % SCAN_NCH; float h = 0.f, ls = 0.f;
        if (k == 0) { unsigned ma[NMETA]; bf16_t mx[NMETA];
#pragma unroll
            for (int i = 0; i < NMETA; ++i) { const size_t r = (size_t)(MR + i) * 512 + c; ma[i] = AB[r]; mx[i] = XC[r]; }
#pragma unroll
            for (int i = 0; i < NMETA; ++i) { const unsigned w = gate_ab(ma[i], bf2f(mx[i]), gc); const float la = bflo(w); h = __builtin_amdgcn_exp2f(la) * h + bfhi(w); ls += la; } }
        const size_t r0 = (size_t)(b * SEQ + k * SCAN_CH) * 512 + c;
#pragma unroll 8
        for (int i = 0; i < SCAN_CH; ++i) { const size_t r = r0 + (size_t)i * 512; const unsigned w = gate_ab(AB[r], bf2f(XC[r]), gc); AB[r] = w; const float la = bflo(w); h = __builtin_amdgcn_exp2f(la) * h + bfhi(w); ls += la; }
        SC[(size_t)u * 512 + c] = (f32x2){ls, h};
    }
}
__device__ __forceinline__ void mix_rows(const Frame& F, int row0, int nrows) {
    const bf16_t* ATT = (const bf16_t*)(F.ws + T_ATT); bf16_t* MIX = (bf16_t*)(F.ws + WS_BUFA);
    for (int i0 = F.wave; i0 < nrows; i0 += 8 * NWAVES) {
        u32x4 at[8];
#pragma unroll
        for (int m = 0; m < 8; ++m) { const int i = i0 + m * NWAVES; at[m] = (u32x4){0u, 0u, 0u, 0u}; if (i < nrows) at[m] = *(const GAS u32x4*)(ATT + (size_t)(row0 + i) * 512 + F.lane * 8); }
#pragma unroll
        for (int m = 0; m < 8; ++m) { const int i = i0 + m * NWAVES; const int row = row0 + i; if (i < nrows) {
#pragma unroll
        for (int which = 0; which < 2; ++which) {
            const u32x4 w = which ? *(const LAS u32x4*)(F.lds + (size_t)i * 1024 + F.lane * 16) : at[m];
            float x[8] = {bflo(w.x), bfhi(w.x), bflo(w.y), bfhi(w.y), bflo(w.z), bfhi(w.z), bflo(w.w), bfhi(w.w)}; float s = 0.f;
#pragma unroll
            for (int j = 0; j < 8; ++j) s += x[j] * x[j];
            const float rs = __builtin_amdgcn_rsqf(wave_sum(s, F.lane) * (1.f / 512) + EPS);
            *(GAS u32x4*)(MIX + (size_t)row * DM + which * 512 + F.lane * 8) = (u32x4){pg8::cvt_pk_bf16(x[0] * rs, x[1] * rs), pg8::cvt_pk_bf16(x[2] * rs, x[3] * rs), pg8::cvt_pk_bf16(x[4] * rs, x[5] * rs), pg8::cvt_pk_bf16(x[6] * rs, x[7] * rs)};
        } } }
    }
}
__device__ __forceinline__ void phase_scan3_mix(const Frame& F, int l) {
    const unsigned* AB = (const unsigned*)((unsigned char*)F.out + D_AB); const bf16_t* XC = (const bf16_t*)(F.ws + T_XC); const f32x2* SC = (const f32x2*)(F.ws + WS_SCAN); const bf16_t* GT = (const bf16_t*)(F.ws + T_GT); const int c = F.tid;
    LAS bf16_t* rl = (LAS bf16_t*)F.lds;
    const GateC gc = gate_consts(F, l, c);
    for (int u = blockIdx.x; u < NB * SCAN_NCH; u += F.G) {
        const int b = u / SCAN_NCH, k = u % SCAN_NCH; float h = 0.f;
        { f32x2 sc[SCAN_NCH];
#pragma unroll
          for (int kk = 0; kk < SCAN_NCH; ++kk) { sc[kk] = (f32x2){0.f, 0.f}; if (kk < k) sc[kk] = SC[(size_t)(b * SCAN_NCH + kk) * 512 + c]; }
#pragma unroll
          for (int kk = 0; kk < SCAN_NCH; ++kk) h = __builtin_amdgcn_exp2f(sc[kk].x) * h + sc[kk].y; }
        if (k == 0) { unsigned ma[NMETA]; bf16_t mx[NMETA], mg[NMETA];
#pragma unroll
            for (int i = 0; i < NMETA; ++i) { const size_t r = (size_t)(MR + i) * 512 + c; ma[i] = AB[r]; mx[i] = XC[r]; mg[i] = GT[r]; }
#pragma unroll
            for (int i = 0; i < NMETA; ++i) { const unsigned w = gate_ab(ma[i], bf2f(mx[i]), gc); h = __builtin_amdgcn_exp2f(bflo(w)) * h + bfhi(w);
                if (b == 0) rl[i * 512 + c] = (bf16_t)f2bf(h * gelu_tanhf_(bf2f(mg[i]))); }
            if (b == 0) { __syncthreads(); mix_rows(F, MR, NMETA); __syncthreads(); } }
        const size_t r0 = (size_t)(b * SEQ + k * SCAN_CH) * 512 + c;
#pragma unroll 16
        for (int i = 0; i < SCAN_CH; ++i) { const size_t r = r0 + (size_t)i * 512; const unsigned w = AB[r]; h = __builtin_amdgcn_exp2f(bflo(w)) * h + bfhi(w); rl[i * 512 + c] = (bf16_t)f2bf(h * gelu_tanhf_(bf2f(GT[r]))); }
        __syncthreads(); mix_rows(F, b * SEQ + k * SCAN_CH, SCAN_CH); __syncthreads();
    }
}

#define EPI_ROWS_BEGIN _Pragma("unroll") for (int ai = 0; ai < 2; ++ai) _Pragma("unroll") for (int m = 0; m < 4; ++m) { const int rloc = ai * 128 + wr * 64 + m * 16 + fr; const int row = u.pm * 256 + rloc; (void)row;
#define EPI_ROWS_END }
__device__ __forceinline__ u32x4 pack8(const f32x4 a, const f32x4 b) { u32x4 w; w.x = pg8::cvt_pk_bf16(a[0], a[1]); w.y = pg8::cvt_pk_bf16(a[2], a[3]); w.z = pg8::cvt_pk_bf16(b[0], b[1]); w.w = pg8::cvt_pk_bf16(b[2], b[3]); return w; }

__device__ __forceinline__ float ssq16(const float* p) { const f32x4 a = *(const GAS f32x4*)p, b = *(const GAS f32x4*)(p + 4), c = *(const GAS f32x4*)(p + 8), d = *(const GAS f32x4*)(p + 12);
    return ((a.x + a.y) + (a.z + a.w)) + ((b.x + b.y) + (b.z + b.w)) + ((c.x + c.y) + (c.z + c.w)) + ((d.x + d.y) + (d.z + d.w)); }
__device__ __forceinline__ float ssq16c(const float* p, int fq, int lane) { const f32x4 a = *(const GAS f32x4*)(p + 4 * fq); float s = (a.x + a.y) + (a.z + a.w); s += shfl_xor_(s, 16, lane); s += shfl_xor_(s, 32, lane); return s; }
__device__ __forceinline__ f32x2 swiglu2(const f32x2 g, const f32x2 u, const f32x2 sneg, const f32x2 ws2) {
    const f32x2 t = g * sneg; const f32x2 d = (f32x2){__builtin_amdgcn_exp2f(t.x), __builtin_amdgcn_exp2f(t.y)} + (f32x2){1.0f, 1.0f};
    const f32x2 r = {__builtin_amdgcn_rcpf(d.x), __builtin_amdgcn_rcpf(d.y)}; return (g * u) * (r * ws2); }
__device__ __forceinline__ f32x4 swiglu4(const f32x4 g, const f32x4 u, float sneg, float ws2) {
    const f32x2 sn = {sneg, sneg}, w2 = {ws2, ws2};
    const f32x2 lo = swiglu2(__builtin_shufflevector(g, g, 0, 1), __builtin_shufflevector(u, u, 0, 1), sn, w2), hi = swiglu2(__builtin_shufflevector(g, g, 2, 3), __builtin_shufflevector(u, u, 2, 3), sn, w2);
    return __builtin_shufflevector(lo, hi, 0, 1, 2, 3); }
__device__ __forceinline__ float sq4(const f32x4 v) { return (v[0] * v[0] + v[1] * v[1]) + (v[2] * v[2] + v[3] * v[3]); }
struct EpiUp {
    static constexpr bool PERM = true; bf16_t* O; int ldc; const float* SSQC; int off, cnt; float invdim;
    template <class S> __device__ __forceinline__ void operator()(const f32x4 (&acc)[2][2][4][2], const pg8::Unit& u, const S&, int wr, int wc, int fr, int fq) const {
        float rsv[2][4];
        EPI_ROWS_BEGIN const float* sp = SSQC + (size_t)row * 16 + off; f32x4 t = *(const GAS f32x4*)sp; if (cnt == 8) t = t + *(const GAS f32x4*)(sp + 4);
            rsv[ai][m] = __builtin_amdgcn_rsqf(((t.x + t.y) + (t.z + t.w)) * invdim + EPS);
        EPI_ROWS_END
        EPI_ROWS_BEGIN const float rs = rsv[ai][m];
            bf16_t* rp = O + (size_t)row * ldc + u.pn * 256 + wc * 32 + 8 * fq;
#pragma unroll
            for (int bj = 0; bj < 2; ++bj) *(GAS u32x4*)(rp + bj * 128) = pack8(acc[ai][bj][m][0] * rs, acc[ai][bj][m][1] * rs);
        EPI_ROWS_END
    }
};
struct EpiKV {
    static constexpr bool PERM = true; bf16_t* Kb; bf16_t* Vb; const float* SSQC; const bf16_t* CQ; const float* rope; const float* kg;
    template <class S> __device__ __forceinline__ void operator()(const f32x4 (&acc)[2][2][4][2], const pg8::Unit& u, const S&, int wr, int wc, int fr, int fq_) const {
        int fq = fq_; asm volatile("" : "+v"(fq));
        const int lane = fr + 16 * fq;
        if (u.pn < 2) {
            const int h = 4 * u.pn + wc; float rsv[2][4], rkv[2][4];
            EPI_ROWS_BEGIN const float* sp = SSQC + (size_t)row * 16; const f32x4 t = *(const GAS f32x4*)(sp + 8); const float rs = __builtin_amdgcn_rsqf(((t.x + t.y) + (t.z + t.w)) * (1.f / KVL) + EPS), skr = sp[12];
                float ss = 0.f;
#pragma unroll
                for (int bj = 0; bj < 2; ++bj)
#pragma unroll
                    for (int n = 0; n < 2; ++n) ss += sq4(acc[ai][bj][m][n]);
                ss += shfl_xor_(ss, 16, lane); ss += shfl_xor_(ss, 32, lane);
                const float rk = __builtin_amdgcn_rsqf((ss * rs * rs + skr) * (1.f / QKH) + EPS); rsv[ai][m] = rs * rk; rkv[ai][m] = rk;
            EPI_ROWS_END
#pragma unroll
            for (int bj = 0; bj < 2; ++bj) { const f32x4 g0 = *(const GAS f32x4*)(kg + 32 * bj + 8 * fq), g1 = *(const GAS f32x4*)(kg + 32 * bj + 8 * fq + 4);
                EPI_ROWS_BEGIN *(GAS u32x4*)((unsigned char*)Kb + ((size_t)(row >> 6) * 8 + h) * 12288 + (4 * bj + fq) * 1024 + (row & 63) * 16) = pack8(acc[ai][bj][m][0] * g0 * rsv[ai][m], acc[ai][bj][m][1] * g1 * rsv[ai][m]); EPI_ROWS_END }
            { const f32x4 gr1 = *(const GAS f32x4*)(kg + 64 + 4 * fq), gr2 = *(const GAS f32x4*)(kg + 80 + 4 * fq);
              u32x2 k1v[2][4], k2v[2][4]; f32x4 ccv[2][4], snv[2][4];
              EPI_ROWS_BEGIN k1v[ai][m] = *(const GAS u32x2*)(CQ + (size_t)row * 512 + 384 + 4 * fq); k2v[ai][m] = *(const GAS u32x2*)(CQ + (size_t)row * 512 + 400 + 4 * fq);
                ccv[ai][m] = *(const GAS f32x4*)(rope + (size_t)row * 32 + 4 * fq); snv[ai][m] = *(const GAS f32x4*)(rope + (size_t)row * 32 + 16 + 4 * fq); EPI_ROWS_END
              EPI_ROWS_BEGIN const float rk = rkv[ai][m]; unsigned char* kp = (unsigned char*)Kb + ((size_t)(row >> 6) * 8 + h) * 12288 + (row & 63) * 16 + (8 + (fq >> 1)) * 1024 + (fq & 1) * 8;
                const u32x2 k1 = k1v[ai][m], k2 = k2v[ai][m]; const f32x4 cc = ccv[ai][m], sn = snv[ai][m];
                const f32x4 y1 = (f32x4){bflo(k1.x), bfhi(k1.x), bflo(k1.y), bfhi(k1.y)} * gr1 * rk, y2 = (f32x4){bflo(k2.x), bfhi(k2.x), bflo(k2.y), bfhi(k2.y)} * gr2 * rk;
                const f32x4 o1 = y1 * cc - y2 * sn, o2 = y2 * cc + y1 * sn;
                *(GAS u32x2*)kp = (u32x2){pg8::cvt_pk_bf16(o1[0], o1[1]), pg8::cvt_pk_bf16(o1[2], o1[3])}; *(GAS u32x2*)(kp + 2048) = (u32x2){pg8::cvt_pk_bf16(o2[0], o2[1]), pg8::cvt_pk_bf16(o2[2], o2[3])};
              EPI_ROWS_END }
        } else {
            float rsv[2][4];
            EPI_ROWS_BEGIN const f32x4 t = *(const GAS f32x4*)(SSQC + (size_t)row * 16 + 8); rsv[ai][m] = __builtin_amdgcn_rsqf(((t.x + t.y) + (t.z + t.w)) * (1.f / KVL) + EPS); EPI_ROWS_END
            EPI_ROWS_BEGIN const float rs = rsv[ai][m];
                unsigned char* vp = (unsigned char*)Vb + ((size_t)(row >> 6) * 8 + 4 * (u.pn - 2) + (wc >> 1)) * 8192 + ((wc & 1) * 4 + ((row & 63) >> 4)) * 1024 + ((row & 15) * 4 + fq) * 16;
#pragma unroll
                for (int bj = 0; bj < 2; ++bj) *(GAS u32x4*)(vp + bj * 2 * 8192) = pack8(acc[ai][bj][m][0] * rs, acc[ai][bj][m][1] * rs);
            EPI_ROWS_END
        }
    }
};
struct EpiProj {
    static constexpr bool PERM = true; unsigned char* ws; const float* SSQ1; float* SSQC;
    template <class S> __device__ __forceinline__ void operator()(const f32x4 (&acc)[2][2][4][2], const pg8::Unit& u, const S&, int wr, int wc, int fr, int fq) const {
        bf16_t* base; int ld, c0; const int lane = fr + 16 * fq;
        if (u.pn < 2) { base = (bf16_t*)(ws + T_CQ); ld = 512; c0 = 256 * u.pn; } else if (u.pn == 2) { base = (bf16_t*)(ws + T_CKV); ld = 256; c0 = 0; }
        else if (u.pn < 5) { base = (bf16_t*)(ws + T_XR); ld = 512; c0 = 256 * (u.pn - 3); } else { base = (bf16_t*)(ws + T_GT); ld = 512; c0 = 256 * (u.pn - 5); }
        float rsv[2][4];
        EPI_ROWS_BEGIN rsv[ai][m] = __builtin_amdgcn_rsqf(ssq16c(SSQ1 + (size_t)row * 16, fq, lane) * (1.f / DM) + EPS); EPI_ROWS_END
        EPI_ROWS_BEGIN const float rs = rsv[ai][m];
            bf16_t* rp = base + (size_t)row * ld + c0 + wc * 32 + 8 * fq; float ss = 0.f;
#pragma unroll
            for (int bj = 0; bj < 2; ++bj) { const f32x4 v0 = acc[ai][bj][m][0] * rs, v1 = acc[ai][bj][m][1] * rs; __builtin_nontemporal_store(pack8(v0, v1), (GAS u32x4*)(rp + bj * 128));
                if (u.pn != 1 || bj == 0) ss += sq4(v0) + sq4(v1); }
            if (u.pn < 3) { ss += shfl_xor_(ss, 16, lane); ss += shfl_xor_(ss, 32, lane); if (fq == 0) SSQC[(size_t)row * 16 + (u.pn == 0 ? 0 : (u.pn == 1 ? 4 : 8)) + wc] = ss; }
            if (u.pn == 1 && wc == 0) { float sk = sq4(acc[ai][1][m][0] * rs) + sq4(acc[ai][1][m][1] * rs); sk += shfl_xor_(sk, 16, lane); sk += shfl_xor_(sk, 32, lane); if (fq == 0) SSQC[(size_t)row * 16 + 12] = sk; }
        EPI_ROWS_END
    }
};
struct EpiGates {
    static constexpr bool PERM = true; unsigned* AB;
    template <class S> __device__ __forceinline__ void operator()(const f32x4 (&acc)[2][2][4][2], const pg8::Unit& u, const S&, int wr, int wc, int fr, int fq) const {
        const int ch0 = 128 * u.pn + wc * 32 + 8 * fq;
        EPI_ROWS_BEGIN GAS u32x4* op = (GAS u32x4*)(AB + (size_t)row * 512 + ch0);
#pragma unroll
            for (int n = 0; n < 2; ++n) { u32x4 o;
#pragma unroll
                for (int i = 0; i < 4; ++i) o[i] = pg8::cvt_pk_bf16(acc[ai][0][m][n][i], acc[ai][1][m][n][i]);
                op[n] = o; }
        EPI_ROWS_END
    }
};
struct EpiRes {
    static constexpr bool PERM = true; bf16_t* HB; float* SSQ; unsigned char* HB8; float ascale;
    template <class S> __device__ __forceinline__ void operator()(const f32x4 (&acc)[2][2][4][2], const pg8::Unit& u, const S&, int wr, int wc, int fr, int fq) const {
        const int col = u.pn * 256 + wc * 32 + 8 * fq, lane = fr + 16 * fq;
        u32x4 rw[2][4][2];
        EPI_ROWS_BEGIN const bf16_t* hp = HB + (size_t)row * DM + col; rw[ai][m][0] = *(const GAS u32x4*)hp; rw[ai][m][1] = *(const GAS u32x4*)(hp + 128); EPI_ROWS_END
        EPI_ROWS_BEGIN bf16_t* hp = HB + (size_t)row * DM + col; float ss = 0.f;
#pragma unroll
            for (int bj = 0; bj < 2; ++bj) { const u32x4 w = rw[ai][m][bj];
                const f32x4 v0 = (f32x4){bflo(w.x), bfhi(w.x), bflo(w.y), bfhi(w.y)} + acc[ai][bj][m][0] * ascale, v1 = (f32x4){bflo(w.z), bfhi(w.z), bflo(w.w), bfhi(w.w)} + acc[ai][bj][m][1] * ascale;
                *(GAS u32x4*)(hp + bj * 128) = pack8(v0, v1); ss += sq4(v0) + sq4(v1);
                if (HB8) *(GAS u32x2*)(HB8 + (size_t)row * DM + col + bj * 128) = (u32x2){pk4_fp8(v0[0], v0[1], v0[2], v0[3]), pk4_fp8(v1[0], v1[1], v1[2], v1[3])}; }
            ss += shfl_xor_(ss, 16, lane); ss += shfl_xor_(ss, 32, lane); if (fq == 0) SSQ[(size_t)row * 16 + u.pn * 4 + wc] = ss;
        EPI_ROWS_END
    }
};
struct EpiSwiGLU {
    static constexpr bool PERM = true; bf16_t* ACT; int ldc; const float* SSQ; float oscale; unsigned char* ACT8;
    static constexpr bool CACHE_ROWS = true;
    template <class S> __device__ __forceinline__ void operator()(const f32x4 (&acc)[2][2][4][2], const pg8::Unit& u, const S&, int wr, int wc, int fr_, int fq_, float (&rc)[8], int& rc_pm) const {
        int fr = fr_, fq = fq_; asm volatile("" : "+v"(fr), "+v"(fq));
        const int lane = fr + 16 * fq;
        if (u.pm != rc_pm) { rc_pm = u.pm;
            EPI_ROWS_BEGIN rc[ai * 4 + m] = __builtin_amdgcn_rsqf(ssq16c(SSQ + (size_t)row * 16, fq, lane) * (1.f / DM) + EPS) * oscale; EPI_ROWS_END }
        const unsigned off0 = __umul24((unsigned)(u.pm * 256 + wr * 64 + fr), (unsigned)ldc) + (unsigned)(u.pn * 128 + wc * 32 + 8 * fq);
        EPI_ROWS_BEGIN const float rs = rc[ai * 4 + m]; f32x4 v0, v1;
#pragma unroll
            for (int i = 0; i < 1; ++i) { const float sneg = -1.4426950408889634f * rs, ws2 = rs * rs; v0 = swiglu4(acc[ai][0][m][0], acc[ai][1][m][0], sneg, ws2); v1 = swiglu4(acc[ai][0][m][1], acc[ai][1][m][1], sneg, ws2); }
            const unsigned off = off0 + (unsigned)((ai * 128 + m * 16) * ldc);
            if (ACT8) *(GAS u32x2*)(ACT8 + off) = (u32x2){pk4_fp8(v0[0], v0[1], v0[2], v0[3]), pk4_fp8(v1[0], v1[1], v1[2], v1[3])};
            else *(GAS u32x4*)(ACT + off) = pack8(v0, v1);
        EPI_ROWS_END
    }
};
struct MoeOrder {               static constexpr bool THIN_META = false;
    int nN, G, c, p0, p1; const LAS int* pfx; const int* list; const f32x2* wlist; unsigned estride;
    __device__ bool next(int i, pg8::Unit& u) const {
        const int nM = p1 - p0, nwg = nM * nN; const long L = (long)i * G + c; if (L >= nwg) return false;
        int wgid = (int)L; { const int q = nwg / pg8::NXCD, r = nwg % pg8::NXCD, xcd = wgid % pg8::NXCD, off = wgid / pg8::NXCD; wgid = (xcd < r ? xcd * (q + 1) : r * (q + 1) + (xcd - r) * q) + off; }
        const int nig = pg8::WGM * nN, gid = wgid / nig, fm = gid * pg8::WGM, gsz = (nM - fm) < pg8::WGM ? (nM - fm) : pg8::WGM;
        const int P = p0 + fm + ((wgid % nig) % gsz), pnn = (wgid % nig) / gsz; int g = 0;
#pragma unroll
        for (int q = 1; q < 16; ++q) g += (pfx[q] <= P) ? 1 : 0;
        g = __builtin_amdgcn_readfirstlane(g);
        u.pm = P; u.pn = pnn; u.grp = g; u.prow = __builtin_amdgcn_readfirstlane((P - pfx[g]) * 256); u.aoff = 0; u.boff = (unsigned)(g & 7) * estride; return true;
    }
    __device__ __forceinline__ int arow(const pg8::Unit& u, int r) const { const int idx = list[(size_t)u.grp * MP + u.prow + r]; return idx < 0 ? MP - 1 : idx; }
};
struct EpiSwiGLUMoe {
    static constexpr bool PERM = true; bf16_t* ACT;
    __device__ __forceinline__ void operator()(const f32x4 (&acc)[2][2][4][2], const pg8::Unit& u, const MoeOrder& S, int wr, int wc, int fr, int fq) const {
        f32x2 wrv[2][4];
        const unsigned off0 = __umul24((unsigned)(u.pm * 256 + wr * 64 + fr), (unsigned)DFE8) + (unsigned)(u.pn * 128 + wc * 32 + 8 * fq);
        EPI_ROWS_BEGIN const size_t li = (size_t)u.grp * MP + u.prow + rloc; f32x2 wr2 = S.wlist[li]; if (S.list[li] < 0) wr2 = (f32x2){0.f, 0.f}; wrv[ai][m] = wr2; EPI_ROWS_END
        EPI_ROWS_BEGIN const f32x2 wr2 = wrv[ai][m]; const float w = wr2.x, rs = wr2.y * (1.f / 64.f); f32x4 v0, v1;
#pragma unroll
            for (int i = 0; i < 1; ++i) { const float sneg = -1.4426950408889634f * rs, ws2 = w * rs * rs; v0 = swiglu4(acc[ai][0][m][0], acc[ai][1][m][0], sneg, ws2); v1 = swiglu4(acc[ai][0][m][1], acc[ai][1][m][1], sneg, ws2); }
            unsigned char* ap = (unsigned char*)ACT + (off0 + (unsigned)((ai * 128 + m * 16) * DFE8));
            *(GAS u32x2*)ap = (u32x2){pk4_fp8(v0[0], v0[1], v0[2], v0[3]), pk4_fp8(v1[0], v1[1], v1[2], v1[3])};
            if (u.pn == 2 * DFE / 256 - 1) *(GAS u32x2*)(ap + 128) = (u32x2){0u, 0u};
        EPI_ROWS_END
    }
};
struct EpiMoeDown {
    static constexpr bool PERM = true; bf16_t* HB; float* SSQ; float* out; int mode;
    __device__ __forceinline__ void operator()(const f32x4 (&acc)[2][2][4][2], const pg8::Unit& u, const MoeOrder& S, int wr, int wc, int fr, int fq) const {
        const int col = u.pn * 256 + wc * 32 + 8 * fq, lane = fr + 16 * fq;
        int tokv[2][4]; u32x4 rw[2][4][2];
        EPI_ROWS_BEGIN tokv[ai][m] = S.list[(size_t)u.grp * MP + u.prow + rloc]; EPI_ROWS_END
        EPI_ROWS_BEGIN const int tok = tokv[ai][m]; const int tr = tok >= 0 ? tok : MP - 1; const bf16_t* hp = HB + (size_t)tr * DM + col; rw[ai][m][0] = *(const GAS u32x4*)hp; rw[ai][m][1] = *(const GAS u32x4*)(hp + 128); EPI_ROWS_END
        EPI_ROWS_BEGIN const int tok = tokv[ai][m]; const bool ok = tok >= 0; const int tr = ok ? tok : MP - 1;
            bf16_t* hp = HB + (size_t)tr * DM + col; float ss = 0.f;
#pragma unroll
            for (int bj = 0; bj < 2; ++bj) { const u32x4 w = rw[ai][m][bj];
                const f32x4 v0 = (f32x4){bflo(w.x), bfhi(w.x), bflo(w.y), bfhi(w.y)} + acc[ai][bj][m][0] * (1.f / 64.f), v1 = (f32x4){bflo(w.z), bfhi(w.z), bflo(w.w), bfhi(w.w)} + acc[ai][bj][m][1] * (1.f / 64.f);
                ss += sq4(v0) + sq4(v1);
                if (mode == 2) { if (ok && tok < MR) { float* op = out + (size_t)tok * DM + col + bj * 128; *(GAS f32x4*)op = v0; *(GAS f32x4*)(op + 4) = v1; } }
                else if (ok) *(GAS u32x4*)(hp + bj * 128) = pack8(v0, v1); }
            if (mode == 1) { ss += shfl_xor_(ss, 16, lane); ss += shfl_xor_(ss, 32, lane); if (fq == 0 && ok) SSQ[(size_t)tok * 16 + u.pn * 4 + wc] = ss; }
        EPI_ROWS_END
    }
};
__device__ __forceinline__ void moe_prefix(const Frame& F) {
    LAS int* pfx = (LAS int*)(F.lds + LDSCTL_OFF); LAS int* npan = pfx + 32;
    __syncthreads();
    if (F.tid < 16) { const unsigned c = __hip_atomic_load(F.ctl + CW_MOE + 64 * F.tid, RLX_AGENT); npan[F.tid] = (int)((c + 255u) >> 8); }
    __syncthreads();
    if (F.tid == 0) { int s = 0;
        for (int g = 0; g < 16; ++g) { pfx[g] = s; s += npan[g]; } pfx[16] = s; }
    __syncthreads();
}

namespace att {
typedef float f32x16 __attribute__((ext_vector_type(16)));
typedef short s16x4 __attribute__((ext_vector_type(4)));
constexpr int KSLOT = 12288, VSLOT = 8192, NSLOT = 3;
constexpr int L_K = 0, L_V = NSLOT * KSLOT, L_WS = L_V + NSLOT * VSLOT, L_OST = L_WS + NWAVES * 256, L_END = L_OST + NWAVES * 4096;
static_assert(L_END <= RING_BYTES, "attention LDS");
__device__ __forceinline__ int crow(int r, int hi) { return (r & 3) + 8 * (r >> 2) + 4 * hi; }
__device__ __forceinline__ float xhalf(float v, int lane) { return shfl_xor_(v, 32, lane); }
__device__ __forceinline__ unsigned cvtpk(float lo, float hi) { typedef float f2 __attribute__((ext_vector_type(2))); typedef __bf16 b2 __attribute__((ext_vector_type(2))); f2 v = {lo, hi}; b2 b = __builtin_convertvector(v, b2); return __builtin_bit_cast(unsigned, b); }
__device__ __forceinline__ float max3f(float a, float b, float c) { float r; asm("v_max3_f32 %0, %1, %2, %3" : "=v"(r) : "v"(a), "v"(b), "v"(c)); return r; }
#define ATT_SB() __builtin_amdgcn_sched_barrier(0)

__device__ __forceinline__ void attn_unit(const Frame& F, int bb, int h, int qb, const float* qg, const float sh) {
    const bf16_t* Q = (const bf16_t*)((unsigned char*)F.out + D_Q); const bf16_t* Kb = (const bf16_t*)(F.ws + T_K); const bf16_t* Vb = (const bf16_t*)(F.ws + T_V); bf16_t* ATT = (bf16_t*)(F.ws + T_ATT);
    const int lane = F.lane, wid = F.wave, r32 = lane & 31, hi = lane >> 5;
    const bool meta = bb < 0;
    const int qrow0 = meta ? MR : bb * SEQ + qb * 256;
    const int krow_b = meta ? 0 : bb * SEQ;
    const int NT = meta ? 1 : 1 + 4 * (qb + 1);
    const int NTw = meta ? 1 : 4 * qb + 2 + (wid >> 1);
    LAS unsigned char* lds = F.lds;
    LAS float* wsf = (LAS float*)(lds + L_WS) + wid * 64;
    const unsigned kvoff = (unsigned)lane * 16u;
    const unsigned vvoff = kvoff;
#define ATT_KROW(t) ((t) == 0 ? MR : krow_b + 64 * ((t) - 1))
#define ATT_DMA_K(t, slot) do { const char* kb_ = pg8::uptr((const char*)Kb + ((size_t)(ATT_KROW(t) >> 6) * 8 + h) * 12288 + wid * 1024); const unsigned ld_ = (unsigned)__builtin_amdgcn_readfirstlane((int)(lds0 + L_K + (slot) * KSLOT + wid * 1024)); \
        glds16(kb_, kvoff, ld_); if (wid < 4) glds16(kb_ + 8192, kvoff, ld_ + 8192u); } while (0)
#define ATT_DMA_V(t, slot) do { const char* vb_ = pg8::uptr((const char*)Vb + ((size_t)(ATT_KROW(t) >> 6) * 8 + h) * 8192 + wid * 1024); \
        glds16(vb_, vvoff, (unsigned)__builtin_amdgcn_readfirstlane((int)(lds0 + L_V + (slot) * VSLOT + wid * 1024))); } while (0)
    const unsigned lds0 = (unsigned)(uintptr_t)lds;
    ATT_DMA_K(0, 0); if (NT > 1) ATT_DMA_K(1, 1); ATT_DMA_V(0, 0);
    bf16x8 qf[6];
    { const int qrow = qrow0 + wid * 32 + r32; const bf16_t* qp = Q + (size_t)qrow * 768 + h * 96 + 8 * hi; float x[6][8]; float ss = 0.f;
#pragma unroll
      for (int c = 0; c < 6; ++c) { const u32x4 w = *(const GAS u32x4*)(qp + 16 * c); x[c][0] = bflo(w.x); x[c][1] = bfhi(w.x); x[c][2] = bflo(w.y); x[c][3] = bfhi(w.y); x[c][4] = bflo(w.z); x[c][5] = bfhi(w.z); x[c][6] = bflo(w.w); x[c][7] = bfhi(w.w);
#pragma unroll
          for (int j = 0; j < 8; ++j) ss += x[c][j] * x[c][j]; }
      ss += xhalf(ss, lane);
      const float rq = __builtin_amdgcn_rsqf(ss * (1.f / QKH) + EPS) * (0.10206207261596575f * 1.4426950408889634f);
#pragma unroll
      for (int c = 0; c < 6; ++c) { const f32x4 g0 = *(const GAS f32x4*)(qg + 16 * c + 8 * hi), g1 = *(const GAS f32x4*)(qg + 16 * c + 8 * hi + 4);
#pragma unroll
          for (int j = 0; j < 4; ++j) { x[c][j] *= rq * g0[j]; x[c][4 + j] *= rq * g1[j]; } }
      const float* rp = (const float*)(F.ws + WS_ROPE) + (size_t)qrow * 32 + 8 * hi;
      const f32x4 c0 = *(const GAS f32x4*)rp, c1 = *(const GAS f32x4*)(rp + 4), s0 = *(const GAS f32x4*)(rp + 16), s1 = *(const GAS f32x4*)(rp + 20);
#pragma unroll
      for (int j = 0; j < 8; ++j) { const float cc = j < 4 ? c0[j & 3] : c1[j & 3], sn = j < 4 ? s0[j & 3] : s1[j & 3]; const float y1 = x[4][j], y2 = x[5][j]; x[4][j] = y1 * cc - y2 * sn; x[5][j] = y2 * cc + y1 * sn; }
#pragma unroll
      for (int c = 0; c < 6; ++c) { const u32x4 w = {cvtpk(x[c][0], x[c][1]), cvtpk(x[c][2], x[c][3]), cvtpk(x[c][4], x[c][5]), cvtpk(x[c][6], x[c][7])}; qf[c] = __builtin_bit_cast(bf16x8, w); } }
    asm volatile("s_waitcnt vmcnt(0)" ::: "memory");
    f32x16 o0 = {}, o1 = {}; float l_run = 0.f;
    const int qpos = meta ? r32 : qb * 256 + wid * 32 + r32;
    const LAS unsigned char* kfb = lds + L_K + hi * 1024 + r32 * 16;
    const LAS unsigned char* vfb = lds + L_V + ((lane >> 4) & 1) * 32 + (lane & 3) * 8 + (4 * hi + ((lane & 15) >> 2)) * 64;
    f32x16 A0, A1, B0, B1;
    u32x4 w0, w1, w2, w3;
#define ATT_VF(ks, d0) ({ const s16x4 lo_ = __builtin_bit_cast(s16x4, __builtin_amdgcn_ds_read_tr16_b64_v4i16((LAS s16x4*)(vp + (d0) * 4096 + (ks) * 1024))); \
        const s16x4 hh_ = __builtin_bit_cast(s16x4, __builtin_amdgcn_ds_read_tr16_b64_v4i16((LAS s16x4*)(vp + (d0) * 4096 + (ks) * 1024 + 512))); \
        (bf16x8){lo_[0], lo_[1], lo_[2], lo_[3], hh_[0], hh_[1], hh_[2], hh_[3]}; })
#define ATT_PACK4(W, P, B) do { W = (u32x4){cvtpk(P[B], P[B + 1]), cvtpk(P[B + 2], P[B + 3]), cvtpk(P[B + 4], P[B + 5]), cvtpk(P[B + 6], P[B + 7])}; \
        sacc += ((P[B] + P[B + 1]) + (P[B + 2] + P[B + 3])) + ((P[B + 4] + P[B + 5]) + (P[B + 6] + P[B + 7])); asm volatile("" : "+v"(W), "+v"(sacc)); } while (0)
#define ATT_EXP4(P, B) do { P[B] = __builtin_amdgcn_exp2f(P[B]); P[B + 1] = __builtin_amdgcn_exp2f(P[B + 1]); P[B + 2] = __builtin_amdgcn_exp2f(P[B + 2]); P[B + 3] = __builtin_amdgcn_exp2f(P[B + 3]); asm volatile("" : "+v"(P)); } while (0)
#define ATT_STEP(C0, C1, P0, P1, t, FIRST) do { \
        const LAS unsigned char* kp = kfb + kslot * KSLOT; const LAS unsigned char* vp = vfb + vslot * VSLOT; float sacc = 0.f; \
        bf16x8 ka0 = *(const LAS bf16x8*)(kp), ka1 = *(const LAS bf16x8*)(kp + 512), kb0, kb1; \
        kb0 = *(const LAS bf16x8*)(kp + 2048); kb1 = *(const LAS bf16x8*)(kp + 2048 + 512); \
        C0 = __builtin_amdgcn_mfma_f32_32x32x16_bf16(ka0, qf[0], (f32x16){}, 0, 0, 0); C1 = __builtin_amdgcn_mfma_f32_32x32x16_bf16(ka1, qf[0], (f32x16){}, 0, 0, 0); \
        ka0 = *(const LAS bf16x8*)(kp + 4096); ka1 = *(const LAS bf16x8*)(kp + 4096 + 512); if (!(FIRST)) ATT_PACK4(w0, P0, 0); ATT_SB(); \
        C0 = __builtin_amdgcn_mfma_f32_32x32x16_bf16(kb0, qf[1], C0, 0, 0, 0); C1 = __builtin_amdgcn_mfma_f32_32x32x16_bf16(kb1, qf[1], C1, 0, 0, 0); \
        kb0 = *(const LAS bf16x8*)(kp + 6144); kb1 = *(const LAS bf16x8*)(kp + 6144 + 512); if (!(FIRST)) ATT_PACK4(w1, P0, 8); ATT_SB(); \
        C0 = __builtin_amdgcn_mfma_f32_32x32x16_bf16(ka0, qf[2], C0, 0, 0, 0); C1 = __builtin_amdgcn_mfma_f32_32x32x16_bf16(ka1, qf[2], C1, 0, 0, 0); \
        ka0 = *(const LAS bf16x8*)(kp + 8192); ka1 = *(const LAS bf16x8*)(kp + 8192 + 512); if (!(FIRST)) ATT_PACK4(w2, P1, 0); ATT_SB(); \
        C0 = __builtin_amdgcn_mfma_f32_32x32x16_bf16(kb0, qf[3], C0, 0, 0, 0); C1 = __builtin_amdgcn_mfma_f32_32x32x16_bf16(kb1, qf[3], C1, 0, 0, 0); \
        kb0 = *(const LAS bf16x8*)(kp + 10240); kb1 = *(const LAS bf16x8*)(kp + 10240 + 512); if (!(FIRST)) ATT_PACK4(w3, P1, 8); ATT_SB(); \
        C0 = __builtin_amdgcn_mfma_f32_32x32x16_bf16(ka0, qf[4], C0, 0, 0, 0); C1 = __builtin_amdgcn_mfma_f32_32x32x16_bf16(ka1, qf[4], C1, 0, 0, 0); \
        bf16x8 vf0, vf1; if (!(FIRST)) { vf0 = ATT_VF(0, 0); vf1 = ATT_VF(0, 1); } ATT_SB(); \
        C0 = __builtin_amdgcn_mfma_f32_32x32x16_bf16(kb0, qf[5], C0, 0, 0, 0); C1 = __builtin_amdgcn_mfma_f32_32x32x16_bf16(kb1, qf[5], C1, 0, 0, 0); \
        l_run += sacc; \
        { const int kb_ = (t) == 0 ? 0 : 64 * ((t) - 1); \
          if ((t) == 0 || (kb_ + 63 > qb * 256 + wid * 32)) { const int lim = ((t) == 0 ? (meta ? (r32 < NMETA ? r32 : NMETA - 1) : NMETA - 1) : qpos) - kb_; \
            _Pragma("unroll") for (int r = 0; r < 16; ++r) { const int kk = crow(r, hi); if (kk > lim) C0[r] = -INFINITY; if (kk + 32 > lim) C1[r] = -INFINITY; } } } \
        if (sh != 0.f) { _Pragma("unroll") for (int r = 0; r < 16; ++r) { C0[r] -= sh; C1[r] -= sh; } } \
        ATT_SB(); \
        if (!(FIRST)) { \
            o0 = __builtin_amdgcn_mfma_f32_32x32x16_bf16(__builtin_bit_cast(bf16x8, w0), vf0, o0, 0, 0, 0); vf0 = ATT_VF(1, 0); ATT_EXP4(C0, 0); ATT_SB(); \
            o1 = __builtin_amdgcn_mfma_f32_32x32x16_bf16(__builtin_bit_cast(bf16x8, w0), vf1, o1, 0, 0, 0); vf1 = ATT_VF(1, 1); ATT_EXP4(C0, 4); ATT_SB(); \
            o0 = __builtin_amdgcn_mfma_f32_32x32x16_bf16(__builtin_bit_cast(bf16x8, w1), vf0, o0, 0, 0, 0); vf0 = ATT_VF(2, 0); ATT_EXP4(C0, 8); ATT_SB(); \
            o1 = __builtin_amdgcn_mfma_f32_32x32x16_bf16(__builtin_bit_cast(bf16x8, w1), vf1, o1, 0, 0, 0); vf1 = ATT_VF(2, 1); ATT_EXP4(C0, 12); ATT_SB(); \
            o0 = __builtin_amdgcn_mfma_f32_32x32x16_bf16(__builtin_bit_cast(bf16x8, w2), vf0, o0, 0, 0, 0); vf0 = ATT_VF(3, 0); ATT_EXP4(C1, 0); ATT_SB(); \
            o1 = __builtin_amdgcn_mfma_f32_32x32x16_bf16(__builtin_bit_cast(bf16x8, w2), vf1, o1, 0, 0, 0); vf1 = ATT_VF(3, 1); ATT_EXP4(C1, 4); ATT_SB(); \
            o0 = __builtin_amdgcn_mfma_f32_32x32x16_bf16(__builtin_bit_cast(bf16x8, w3), vf0, o0, 0, 0, 0); ATT_EXP4(C1, 8); ATT_SB(); \
            o1 = __builtin_amdgcn_mfma_f32_32x32x16_bf16(__builtin_bit_cast(bf16x8, w3), vf1, o1, 0, 0, 0); ATT_EXP4(C1, 12); ATT_SB(); \
        } else { ATT_EXP4(C0, 0); ATT_EXP4(C0, 4); ATT_EXP4(C0, 8); ATT_EXP4(C0, 12); ATT_EXP4(C1, 0); ATT_EXP4(C1, 4); ATT_EXP4(C1, 8); ATT_EXP4(C1, 12); } \
    } while (0)
#define ATT_DRAIN(P0, P1) do { const LAS unsigned char* vp = vfb + vslot * VSLOT; float sacc = 0.f; \
        ATT_PACK4(w0, P0, 0); ATT_PACK4(w1, P0, 8); ATT_PACK4(w2, P1, 0); ATT_PACK4(w3, P1, 8); l_run += sacc; \
        o0 = __builtin_amdgcn_mfma_f32_32x32x16_bf16(__builtin_bit_cast(bf16x8, w0), ATT_VF(0, 0), o0, 0, 0, 0); o1 = __builtin_amdgcn_mfma_f32_32x32x16_bf16(__builtin_bit_cast(bf16x8, w0), ATT_VF(0, 1), o1, 0, 0, 0); \
        o0 = __builtin_amdgcn_mfma_f32_32x32x16_bf16(__builtin_bit_cast(bf16x8, w1), ATT_VF(1, 0), o0, 0, 0, 0); o1 = __builtin_amdgcn_mfma_f32_32x32x16_bf16(__builtin_bit_cast(bf16x8, w1), ATT_VF(1, 1), o1, 0, 0, 0); \
        o0 = __builtin_amdgcn_mfma_f32_32x32x16_bf16(__builtin_bit_cast(bf16x8, w2), ATT_VF(2, 0), o0, 0, 0, 0); o1 = __builtin_amdgcn_mfma_f32_32x32x16_bf16(__builtin_bit_cast(bf16x8, w2), ATT_VF(2, 1), o1, 0, 0, 0); \
        o0 = __builtin_amdgcn_mfma_f32_32x32x16_bf16(__builtin_bit_cast(bf16x8, w3), ATT_VF(3, 0), o0, 0, 0, 0); o1 = __builtin_amdgcn_mfma_f32_32x32x16_bf16(__builtin_bit_cast(bf16x8, w3), ATT_VF(3, 1), o1, 0, 0, 0); \
    } while (0)
#define ATT_ITER(C0, C1, P0, P1, t, FIRST) do { \
        if ((t) + 1 < NT) { if (wid < 4) asm volatile("s_waitcnt vmcnt(3)" ::: "memory"); else asm volatile("s_waitcnt vmcnt(2)" ::: "memory"); } else asm volatile("s_waitcnt vmcnt(0)" ::: "memory"); \
        __builtin_amdgcn_s_barrier(); asm volatile("" ::: "memory"); \
        if ((t) + 2 < NT) ATT_DMA_K((t) + 2, kslot == 0 ? 2 : kslot - 1); \
        if ((t) + 1 < NT) ATT_DMA_V((t) + 1, kslot == 2 ? 0 : kslot + 1); \
        if (FIRST) { ATT_STEP(C0, C1, P0, P1, t, true); } else { if ((t) < NTw) ATT_STEP(C0, C1, P0, P1, t, false); else if ((t) == NTw) ATT_DRAIN(P0, P1); } \
        vslot = kslot; kslot = kslot == 2 ? 0 : kslot + 1; \
    } while (0)
    int kslot = 0, vslot = 2;
    ATT_ITER(A0, A1, B0, B1, 0, true);
    for (int t = 1; t <= NT; t += 2) {
        ATT_ITER(B0, B1, A0, A1, t, false);
        if (t + 1 > NT) break;
        ATT_ITER(A0, A1, B0, B1, t + 1, false);
    }
    const float lt = l_run + xhalf(l_run, lane);
    if (hi == 0) wsf[32 + r32] = 1.0f / lt;
    asm volatile("s_waitcnt lgkmcnt(0)" ::: "memory");
    LAS bf16_t* stg = (LAS bf16_t*)(lds + L_OST) + wid * 2048;
#pragma unroll
    for (int g = 0; g < 4; ++g) { const f32x4 ff = *(const LAS f32x4*)(wsf + 32 + 8 * g + 4 * hi);
#pragma unroll
        for (int e = 0; e < 4; ++e) { const int q = 8 * g + 4 * hi + e; const bool ok = !meta || (wid == 0 && q < NMETA);
            stg[q * 64 + r32] = (bf16_t)f2bf(ok ? o0[4 * g + e] * ff[e] : 0.f); stg[q * 64 + 32 + r32] = (bf16_t)f2bf(ok ? o1[4 * g + e] * ff[e] : 0.f); } }
    asm volatile("s_waitcnt lgkmcnt(0)" ::: "memory");
    bf16_t* op = ATT + (size_t)(qrow0 + wid * 32) * 512 + h * 64;
#pragma unroll
    for (int i = 0; i < 4; ++i) { int ln = lane; asm volatile("" : "+v"(ln));
        const int row = i * 8 + (ln >> 3), ch = ln & 7; const u32x4 v = *(const LAS u32x4*)(stg + row * 64 + ch * 8); *(GAS u32x4*)(op + (size_t)row * 512 + ch * 8) = v; }
    asm volatile("s_waitcnt vmcnt(0) lgkmcnt(0)" ::: "memory"); __builtin_amdgcn_s_barrier(); asm volatile("" ::: "memory");
#undef ATT_KROW
#undef ATT_DMA_K
#undef ATT_DMA_V
#undef ATT_VF
#undef ATT_PACK4
#undef ATT_EXP4
#undef ATT_STEP
#undef ATT_DRAIN
#undef ATT_ITER
}
#undef ATT_SB
}
__device__ __forceinline__ void phase_attn(const Frame& F, int l) {
    const float* qg = (const float*)F.in(I_Q_HEAD_G) + l * QKH;
    float sh; { const float* kgp = (const float*)F.in(I_K_HEAD_G) + l * QKH; float gm = 0.f, km = 0.f;
        for (int i = F.lane; i < QKH; i += 64) { gm = fmaxf(gm, fabsf(qg[i])); km = fmaxf(km, fabsf(kgp[i])); }
#pragma unroll
        for (int o = 1; o < 64; o <<= 1) { gm = fmaxf(gm, shfl_xor_(gm, o, F.lane)); km = fmaxf(km, shfl_xor_(km, o, F.lane)); }
        const float B = gm * km * 14.135f; sh = __builtin_bit_cast(float, __builtin_amdgcn_readfirstlane(__builtin_bit_cast(int, B > 90.f ? B - 64.f : 0.f))); }
    const bool fast = F.G == 256; const int v = F.vcu, c = v & 3; const int nu = fast ? (v < NH ? 5 : 4) : (NB * NH * 16 + NH - v + F.G - 1) / F.G;
    for (int i = 0; i < nu; ++i) {
        int bb, h, qb;
        if (fast) { if (i < 4) { const int bh = v >> 2; bb = bh >> 3; h = bh & 7; qb = i == 0 ? 15 - c : (i == 1 ? 8 + c : (i == 2 ? 7 - c : c)); } else { bb = -1; h = v; qb = 0; } }
        else { const int u = v + i * F.G; if (u < NB * NH * 16) { bb = u >> 7; h = (u >> 4) & 7; qb = u & 15; } else { bb = -1; h = u - NB * NH * 16; qb = 0; } }
        att::attn_unit(F, bb, h, qb, qg, sh);
    }
}

template <int MODE> __device__ __forceinline__ void mini_phase(const Frame& F, const bf16_t* A, int lda, const bf16_t* Bt, int ldb, int K, int ntasks, bf16_t* O, const float* SSQin, float* SSQout,
                                                           bf16_t* O2 = nullptr, const float* kgain = nullptr, const bf16_t* CQp = nullptr, const float* ropep = nullptr) {
    const int lane = F.lane, v = F.wave, fr = lane & 15, fq = lane >> 4, tile = v & 3, hv = v >> 2;
    LAS f32x4* part = (LAS f32x4*)F.lds; LAS float* sq = (LAS float*)(F.lds + 8192);
    for (int task = MODE == 2 ? (int)blockIdx.x : F.G - 1 - (int)blockIdx.x; task < ntasks; task += F.G) {
        int brow, kbeg, kend, acol = 0;
        if (MODE == 0) { brow = task < 8 ? 256 * (task >> 2) + 128 * (tile >> 1) + 32 * (task & 3) + 16 * (tile & 1) : 512 + 64 * (task - 8) + 16 * tile; kbeg = hv * (K / 2); kend = kbeg + K / 2; }
        else if (MODE == 2) { brow = 64 * task + 16 * tile; kbeg = hv * (K / 2); kend = kbeg + K / 2; }
        else if (MODE == 3) { const int hid = 64 * task + 16 * tile; brow = 256 * (hid >> 7) + (hid & 127) + 128 * hv; kbeg = 0; kend = K; }
        else { const int ch = 64 * task + 16 * tile, j = ch >> 7; brow = 256 * j + (ch & 127) + 128 * hv; acol = 256 * (j >> 1); kbeg = 0; kend = K; }
        const bf16_t* ap = A + (size_t)(MR + fr) * lda + acol + 8 * fq; const bf16_t* bp = Bt + (size_t)(brow + fr) * ldb + 8 * fq;
        f32x4 acc = {0.f, 0.f, 0.f, 0.f};
        for (int k = kbeg; k < kend; k += 512) {
            bf16x8 a16[16], b16[16];
#pragma unroll
            for (int i = 0; i < 16; ++i) if (k + 32 * i < kend) { a16[i] = *(const GAS bf16x8*)(ap + k + 32 * i); b16[i] = *(const GAS bf16x8*)(bp + k + 32 * i); }
#pragma unroll
            for (int i = 0; i < 16; ++i) if (k + 32 * i < kend) acc = __builtin_amdgcn_mfma_f32_16x16x32_bf16(b16[i], a16[i], acc, 0, 0, 0);
        }
        part[v * 64 + lane] = acc;
        __syncthreads();
        const int row = MR + fr; f32x4 xk = {0.f, 0.f, 0.f, 0.f};
        if (v < 4) {
            const f32x4 x = (MODE == 0 || MODE == 2) ? part[v * 64 + lane] + part[(v + 4) * 64 + lane] : part[v * 64 + lane]; const f32x4 y = part[(v + 4) * 64 + lane];
            const int col = 64 * task + 16 * tile + 4 * fq;
            if (MODE == 0) { const f32x4 t = *(const GAS f32x4*)(SSQin + (size_t)row * 16 + 8); const float rs = __builtin_amdgcn_rsqf(((t.x + t.y) + (t.z + t.w)) * (1.f / KVL) + EPS);
                xk = x * rs;
                if (task < 8) { float ss = sq4(xk); ss += shfl_xor_(ss, 16, lane); ss += shfl_xor_(ss, 32, lane); if (fq == 0) sq[tile * 16 + fr] = ss; }
                else { const int dv = 16 * tile + 4 * fq; *(GAS u32x2*)((unsigned char*)O2 + ((size_t)(row >> 6) * 8 + (task - 8)) * 8192 + ((dv >> 5) * 4 + ((row & 63) >> 4)) * 1024 + ((row & 15) * 4 + ((dv & 31) >> 3)) * 16 + (dv & 7) * 2) = (u32x2){pg8::cvt_pk_bf16(xk[0], xk[1]), pg8::cvt_pk_bf16(xk[2], xk[3])}; } }
            else if (MODE == 1) { *(GAS u32x4*)((unsigned*)O + (size_t)row * 512 + col) = (u32x4){pg8::cvt_pk_bf16(x[0], y[0]), pg8::cvt_pk_bf16(x[1], y[1]), pg8::cvt_pk_bf16(x[2], y[2]), pg8::cvt_pk_bf16(x[3], y[3])}; }
            else if (MODE == 2) { bf16_t* hp = O + (size_t)row * DM + col; const u32x2 w = *(const GAS u32x2*)hp; const f32x4 nv = (f32x4){bflo(w.x), bfhi(w.x), bflo(w.y), bfhi(w.y)} + x;
                *(GAS u32x2*)hp = (u32x2){pg8::cvt_pk_bf16(nv[0], nv[1]), pg8::cvt_pk_bf16(nv[2], nv[3])};
                if (O2) *(GAS unsigned*)((unsigned char*)O2 + (size_t)row * DM + col) = pk4_fp8(nv[0], nv[1], nv[2], nv[3]);
                float ss = sq4(nv); ss += shfl_xor_(ss, 16, lane); ss += shfl_xor_(ss, 32, lane); if (fq == 0) sq[tile * 16 + fr] = ss; }
            else { const float rs = __builtin_amdgcn_rsqf(ssq16(SSQin + (size_t)row * 16) * (1.f / DM) + EPS); f32x4 o;
#pragma unroll
                for (int i = 0; i < 4; ++i) o[i] = siluf_(x[i] * rs) * (y[i] * rs);
                *(GAS u32x2*)(O + (size_t)row * DFF + col) = (u32x2){pg8::cvt_pk_bf16(o[0], o[1]), pg8::cvt_pk_bf16(o[2], o[3])}; }
        }
        __syncthreads();
        if (MODE == 2 && v == 0 && lane < 16) SSQout[(size_t)(MR + lane) * 16 + task] = (sq[lane] + sq[16 + lane]) + (sq[32 + lane] + sq[48 + lane]);
        if (MODE == 0 && task < 8 && v < 4) {
            const float rk = __builtin_amdgcn_rsqf(((sq[fr] + sq[16 + fr]) + (sq[32 + fr] + sq[48 + fr]) + SSQin[(size_t)row * 16 + 12]) * (1.f / QKH) + EPS);
            unsigned char* kt = (unsigned char*)O + ((size_t)(row >> 6) * 8 + task) * 12288 + (row & 63) * 16; const int d0 = 16 * tile + 4 * fq; const f32x4 g = *(const GAS f32x4*)(kgain + d0); const f32x4 o = xk * g * rk;
            *(GAS u32x2*)(kt + (d0 >> 3) * 1024 + (fq & 1) * 8) = (u32x2){pg8::cvt_pk_bf16(o[0], o[1]), pg8::cvt_pk_bf16(o[2], o[3])};
            if (v == 0) { const f32x4 gr1 = *(const GAS f32x4*)(kgain + 64 + 4 * fq), gr2 = *(const GAS f32x4*)(kgain + 80 + 4 * fq);
                const u32x2 k1 = *(const GAS u32x2*)(CQp + (size_t)row * 512 + 384 + 4 * fq), k2 = *(const GAS u32x2*)(CQp + (size_t)row * 512 + 400 + 4 * fq);
                const f32x4 cc = *(const GAS f32x4*)(ropep + (size_t)row * 32 + 4 * fq), sn = *(const GAS f32x4*)(ropep + (size_t)row * 32 + 16 + 4 * fq);
                const f32x4 y1 = (f32x4){bflo(k1.x), bfhi(k1.x), bflo(k1.y), bfhi(k1.y)} * gr1 * rk, y2 = (f32x4){bflo(k2.x), bfhi(k2.x), bflo(k2.y), bfhi(k2.y)} * gr2 * rk;
                const f32x4 o1 = y1 * cc - y2 * sn, o2 = y2 * cc + y1 * sn;
                unsigned char* kr = kt + (8 + (fq >> 1)) * 1024 + (fq & 1) * 8;
                *(GAS u32x2*)kr = (u32x2){pg8::cvt_pk_bf16(o1[0], o1[1]), pg8::cvt_pk_bf16(o1[2], o1[3])}; *(GAS u32x2*)(kr + 2048) = (u32x2){pg8::cvt_pk_bf16(o2[0], o2[1]), pg8::cvt_pk_bf16(o2[2], o2[3])}; } }
    }
    __syncthreads();
}

struct PlainOrder : pg8::StaticOrder { static constexpr bool THIN_META = false; };
struct ColOrder : pg8::StaticOrder {
    static constexpr bool THIN_META = false;
    unsigned astride;
    __device__ bool next(int i, pg8::Unit& u) const { const bool ok = pg8::StaticOrder::next(i, u); if (ok) u.aoff = (unsigned)(u.pn >> 1) * astride; return ok; }
};
#define GRID_BAR() xcd_barrier(bar, wave_s)
#define FRAME() const Frame F = mkframe(lds_raw, wave_s); unsigned char* const ws = F.ws; unsigned char* const wb = ws + WS_W; unsigned char* const lw = wb + (size_t)l * W_LAYER; const int G = F.G, cid = (int)blockIdx.x; (void)wb; (void)lw; (void)G; (void)cid
template <int l> __device__ __forceinline__ void layer_phases(unsigned char* lds_raw, const XcdBarrier& bar, const int wave_s) {
    { FRAME();
      pg8::Gemm g{(const bf16_t*)(ws + WS_HB), (const bf16_t*)(lw + W_IN), DM, DM, DM}; pg8::StaticOrder S; S.init(NPANEL, NPROJ / 256, G, cid);
      EpiProj E{ws, (const float*)(ws + WS_SSQ1), (float*)(ws + WS_SSQC)}; pg8::gemm_phase<EpiProj, pg8::StaticOrder>(F.lds, g, S, E, F.tid); }
    if constexpr (l == 2) { FRAME(); constexpr int NIDLE = 256 - (NPANEL * (NPROJ / 256)) % 256;
      if (G == 256 && cid >= 256 - NIDLE) conv_moe_weights(F, 1, 0, JIT_SPLIT, cid - (256 - NIDLE), NIDLE, false); }
    GRID_BAR();
    { FRAME(); phase_e1(F, l); if (l & 1) phase_moe_init(F); if (l == 2) conv_moe_weights(F, 1, F.G == 256 ? JIT_SPLIT : 0); }
    GRID_BAR();
    { FRAME(); pg8::Gemm g{(const bf16_t*)(ws + T_CQ), (const bf16_t*)(lw + W_UQ), 512, QL, QL}; pg8::StaticOrder S; S.init(NPANEL, 768 / 256, G, cid);
      EpiUp E{(bf16_t*)((unsigned char*)F.out + D_Q), 768, (const float*)(ws + WS_SSQC), 0, 8, 1.f / QL}; pg8::gemm_phase<EpiUp, pg8::StaticOrder>(F.lds, g, S, E, F.tid); }
    { FRAME(); pg8::Gemm g{(const bf16_t*)(ws + T_CKV), (const bf16_t*)(lw + W_UKV), 256, KVL, KVL}; PlainOrder S; S.init(NPANEL - 1, 1024 / 256, G, cid);
      const float* kg = (const float*)F.in(I_K_HEAD_G) + l * QKH;
      EpiKV E{(bf16_t*)(ws + T_K), (bf16_t*)(ws + T_V), (const float*)(ws + WS_SSQC), (const bf16_t*)(ws + T_CQ), (const float*)(ws + WS_ROPE), kg}; pg8::gemm_phase<EpiKV, PlainOrder>(F.lds, g, S, E, F.tid); }
      { FRAME(); const float* kg = (const float*)F.in(I_K_HEAD_G) + l * QKH; mini_phase<0>(F, (const bf16_t*)(ws + T_CKV), 256, (const bf16_t*)(lw + W_UKV), KVL, KVL, 16, (bf16_t*)(ws + T_K), (const float*)(ws + WS_SSQC), nullptr, (bf16_t*)(ws + T_V), kg, (const bf16_t*)(ws + T_CQ), (const float*)(ws + WS_ROPE)); }
    { FRAME(); pg8::Gemm g{(const bf16_t*)(ws + T_XC), (const bf16_t*)(lw + W_G), 512, 256, 256}; ColOrder S; S.init(NPANEL - 1, 4, G, cid); S.astride = 512;
      EpiGates E{(unsigned*)((unsigned char*)F.out + D_AB)}; pg8::gemm_phase<EpiGates, ColOrder>(F.lds, g, S, E, F.tid); }
      { FRAME(); mini_phase<1>(F, (const bf16_t*)(ws + T_XC), 512, (const bf16_t*)(lw + W_G), 256, 256, 8, (bf16_t*)((unsigned char*)F.out + D_AB), nullptr, nullptr); }
    GRID_BAR();
    { FRAME(); phase_scan1(F, l); } { FRAME(); phase_attn(F, l); }
    GRID_BAR();
    { FRAME(); phase_scan3_mix(F, l); }
    GRID_BAR();
    { FRAME();
      pg8::Gemm g{(const bf16_t*)(ws + WS_BUFA), (const bf16_t*)(lw + W_OUT), DM, DM, DM}; PlainOrder S; S.init(NPANEL - 1, DM / 256, G, cid);
      EpiRes E{F.hb, (float*)(ws + WS_SSQ2), ws + WS_HB8, 1.f}; pg8::gemm_phase<EpiRes, PlainOrder>(F.lds, g, S, E, F.tid); }
      { FRAME(); mini_phase<2>(F, (const bf16_t*)(ws + WS_BUFA), DM, (const bf16_t*)(lw + W_OUT), DM, DM, 16, F.hb, nullptr, (float*)(ws + WS_SSQ2), (bf16_t*)(ws + WS_HB8)); }
    GRID_BAR();
    if constexpr (!(l & 1)) {
        constexpr int j = l >> 1;
        { FRAME(); unsigned char* dw = wb + W_DENSE + (size_t)j * W_DENSE_STRIDE;
          pg8::Gemm g{(const bf16_t*)(ws + WS_HB8), (const bf16_t*)(ws + WS_W8 + (size_t)j * SZ_W8), DM / 2, DM / 2, DM / 2}; PlainOrder S; S.init(NPANEL - 1, 2 * DFF / 256, G, cid);
          EpiSwiGLU E{(bf16_t*)(ws + T_ACT), DFF, (const float*)(ws + WS_SSQ2), 1.f / 64.f, ws + T_ACT}; pg8::gemm_phase<EpiSwiGLU, PlainOrder, false, true>(F.lds, g, S, E, F.tid); }
          { FRAME(); unsigned char* dw = wb + W_DENSE + (size_t)j * W_DENSE_STRIDE; mini_phase<3>(F, (const bf16_t*)(ws + WS_HB), DM, (const bf16_t*)dw, DM, DM, DFF / 64, (bf16_t*)(ws + T_ACT), (const float*)(ws + WS_SSQ2), nullptr); }
        GRID_BAR();
        { FRAME(); unsigned char* dw = wb + W_DENSE + (size_t)j * W_DENSE_STRIDE;
          pg8::Gemm g{(const bf16_t*)(ws + T_ACT), (const bf16_t*)(wb + W_MOE + NE * SZ_MUP8 + (size_t)j * SZ_DN8), DFF / 2, DFF / 2, DFF / 2}; PlainOrder S; S.init(NPANEL - 1, DM / 256, G, cid);
          EpiRes E{F.hb, (float*)(ws + WS_SSQ1), nullptr, 1.f / 64.f}; pg8::gemm_phase<EpiRes, PlainOrder, false, true>(F.lds, g, S, E, F.tid); }
          { FRAME(); unsigned char* dw = wb + W_DENSE + (size_t)j * W_DENSE_STRIDE; mini_phase<2>(F, (const bf16_t*)(ws + T_ACT), DFF, (const bf16_t*)(dw + SZ_UP), DFF, DFF, 16, F.hb, nullptr, (float*)(ws + WS_SSQ1)); }
        GRID_BAR();
    } else {
        constexpr int j = l >> 1;
        { FRAME(); phase_route(F, j); }
        GRID_BAR();
        { FRAME(); const LAS int* pfx = (const LAS int*)(F.lds + LDSCTL_OFF);
          moe_prefix(F);
          pg8::Gemm g{(const bf16_t*)(ws + WS_HB8), (const bf16_t*)(wb + W_MOE), DM / 2, DM / 2, DM / 2};
          MoeOrder S{2 * DFE / 256, G, cid, 0, pfx[16], pfx, (const int*)(ws + WS_LIST), (const f32x2*)(ws + WS_WLIST), (unsigned)SZ_MUP8};
          EpiSwiGLUMoe E{(bf16_t*)(ws + T_ACT)}; pg8::gemm_phase<EpiSwiGLUMoe, MoeOrder, true, true>(F.lds, g, S, E, F.tid); }
        GRID_BAR();
        { FRAME(); const LAS int* pfx = (const LAS int*)(F.lds + LDSCTL_OFF);
          moe_prefix(F);
          pg8::Gemm g{(const bf16_t*)(ws + T_ACT), (const bf16_t*)(wb + W_MOE_DN), DFE8 / 2, DFE8 / 2, DFE8 / 2};
          MoeOrder S{DM / 256, G, cid, 0, pfx[8], pfx, (const int*)(ws + WS_LIST), (const f32x2*)(ws + WS_WLIST), (unsigned)SZ_MDN8};
          EpiMoeDown E{F.hb, (float*)(ws + WS_SSQ1), F.out, 0}; pg8::gemm_phase<EpiMoeDown, MoeOrder, false, true>(F.lds, g, S, E, F.tid); }
        GRID_BAR();
        { FRAME(); const LAS int* pfx = (const LAS int*)(F.lds + LDSCTL_OFF);
          moe_prefix(F);
          pg8::Gemm g{(const bf16_t*)(ws + T_ACT), (const bf16_t*)(wb + W_MOE_DN), DFE8 / 2, DFE8 / 2, DFE8 / 2};
          MoeOrder S{DM / 256, G, cid, pfx[8], pfx[16], pfx, (const int*)(ws + WS_LIST), (const f32x2*)(ws + WS_WLIST), (unsigned)SZ_MDN8};
          EpiMoeDown E{F.hb, (float*)(ws + WS_SSQ1), F.out, l == DEPTH - 1 ? 2 : 1}; pg8::gemm_phase<EpiMoeDown, MoeOrder, false, true>(F.lds, g, S, E, F.tid); }
        if (l != DEPTH - 1) GRID_BAR();
    }
}
__global__ void __launch_bounds__(NTHREADS, 2) trunk_fwd(Args args) {
    extern __shared__ __attribute__((aligned(16))) unsigned char lds_raw[];
    const int wave_s = __builtin_amdgcn_readfirstlane((int)threadIdx.x >> 6);
    {
        LAS unsigned char* l3 = (LAS unsigned char*)lds_raw; const int t0 = wave_s * 64 + (int)__builtin_amdgcn_mbcnt_hi(~0u, __builtin_amdgcn_mbcnt_lo(~0u, 0u));
        for (int u = t0; u < (LDS_BYTES - LDSCTL_OFF) / 4; u += NTHREADS) ((LAS unsigned*)(l3 + LDSCTL_OFF))[u] = 0u;
        __syncthreads();
    }
    XcdBarrier bar = xcd_barrier_post((unsigned*)(args.ws + WS_CTL) + CW_BAR, (volatile LAS unsigned*)((LAS unsigned char*)lds_raw + MISC_OFF) + 8, wave_s);
    { const int l = 0; FRAME(); conv_mixer_dense_weights(F); conv_moe_weights(F, 0); prologue_misc(F); phase_x_to_hb(F); }
    GRID_BAR();
    layer_phases<0>(lds_raw, bar, wave_s);
    layer_phases<1>(lds_raw, bar, wave_s);
    layer_phases<2>(lds_raw, bar, wave_s);
    layer_phases<3>(lds_raw, bar, wave_s);
}
#undef GRID_BAR
#undef FRAME

extern "C" void kernel_launch(void* const* d_in, const int* in_sizes, int n_in, void* d_out, int out_size, void* d_ws, size_t ws_size, hipStream_t stream) {
    static int grid = 0;
    if (grid == 0) {
        if (n_in != 29 || out_size != MR * DM || ws_size < WS_END) { fprintf(stderr, "kernel_launch: unexpected shapes (n_in %d out %d ws %zu)\n", n_in, out_size, ws_size); grid = -1; return; }
        int dev = 0, cus = 0, per_cu = 0;
        if (hipGetDevice(&dev) != hipSuccess || hipDeviceGetAttribute(&cus, hipDeviceAttributeMultiprocessorCount, dev) != hipSuccess) { grid = -1; return; }
        if (hipFuncSetAttribute((const void*)trunk_fwd, hipFuncAttributeMaxDynamicSharedMemorySize, LDS_BYTES) != hipSuccess) { fprintf(stderr, "kernel_launch: hipFuncSetAttribute failed\n"); grid = -1; return; }
        if (hipOccupancyMaxActiveBlocksPerMultiprocessor(&per_cu, (const void*)trunk_fwd, NTHREADS, LDS_BYTES) != hipSuccess || per_cu < 1) { fprintf(stderr, "kernel_launch: occupancy query says %d\n", per_cu); }
        (void)hipGetLastError();
        grid = cus;
    }
    if (grid < 0) return;
    (void)hipMemsetAsync((char*)d_ws + WS_CTL, 0, CTL_ZERO_BYTES, stream);
    Args a{};
    for (int i = 0; i < 29; ++i) a.in[i] = d_in[i];
    a.out = (float*)d_out; a.ws = (unsigned char*)d_ws;
    hipLaunchKernelGGL(trunk_fwd, dim3(grid), dim3(NTHREADS), LDS_BYTES, stream, a);
}
```

```cpp
#include <hip/hip_runtime.h>
#include <cstdio>
#include <cstdint>
#include <type_traits>

#define LAS __attribute__((address_space(3)))
#define GAS __attribute__((address_space(1)))
typedef unsigned short bf16_t;
typedef short bf16x8 __attribute__((ext_vector_type(8)));
typedef float f32x4 __attribute__((ext_vector_type(4)));
typedef float f32x2 __attribute__((ext_vector_type(2)));
typedef unsigned u32x4 __attribute__((ext_vector_type(4)));
typedef unsigned u32x2 __attribute__((ext_vector_type(2)));
typedef GAS unsigned gu32;

constexpr int NB = 8, SEQ = 4096, NMETA = 16, DM = 1024, DEPTH = 4;
constexpr int MR = NB * SEQ;
constexpr int MP = MR + 256;
constexpr int NPANEL = MP / 256;
constexpr int MVALID = MR + NMETA;
constexpr int QL = 384, KVL = 256, ROPE = 32, DR = 512, DIN = 1696;
constexpr int NH = 8, QKN = 64, QKH = 96, VH = 64;
constexpr int DFF = 2816, NE = 8, DFE = 1408;
constexpr int NPROJ = 1792;
constexpr float EPS = 1e-6f;
constexpr int NWAVES = 8, NTHREADS = 512;
constexpr int SCAN_CH = 128, SCAN_NCH = SEQ / SCAN_CH;

constexpr size_t MiB = 1u << 20, QMiB = 1u << 18;
constexpr size_t WS_CTL = 0, CTL_ZERO_BYTES = 1 * MiB;
constexpr size_t WS_ROPE = 4 * QMiB;
constexpr size_t WS_LIST = 21 * QMiB;
constexpr size_t WS_WLIST = 30 * QMiB;
constexpr size_t WS_SCAN = 47 * QMiB;
constexpr size_t WS_SSQ1 = 51 * QMiB;
constexpr size_t WS_SSQ2 = 60 * QMiB;
constexpr size_t WS_SSQC = 69 * QMiB;
constexpr size_t WS_W = 20 * MiB;
constexpr size_t WS_BUFA = 148 * MiB;
constexpr size_t WS_T = 213 * MiB;
constexpr size_t WS_HB = 400 * MiB;
constexpr size_t WS_W8 = 465 * MiB;
constexpr size_t SZ_W8 = (size_t)2 * DFF * DM;
constexpr size_t WS_HB8 = 476 * MiB;
constexpr size_t WS_END = 509 * MiB;
static_assert(WS_W8 + 2 * SZ_W8 <= WS_HB8 && WS_HB8 + (size_t)MP * DM <= WS_END, "fp8 buffers");
constexpr size_t SZ512 = (size_t)MP * 512 * 2;
static_assert(WS_ROPE + (size_t)MP * 32 * 4 <= WS_LIST && WS_LIST + (size_t)16 * MP * 4 <= WS_WLIST && WS_WLIST + (size_t)16 * MP * 8 <= WS_SCAN && WS_SCAN + MiB <= WS_SSQ1 && WS_SSQ1 + (size_t)MP * 64 <= WS_SSQ2 && WS_SSQ2 + (size_t)MP * 64 <= WS_SSQC && WS_SSQC + (size_t)MP * 64 <= WS_W, "small tables");
constexpr size_t T_CQ = WS_T, T_CKV = T_CQ + SZ512, T_XR = T_CKV + SZ512 / 2, T_XC = T_XR + SZ512, T_GT = T_XC + SZ512, T_RNN = T_GT + SZ512, T_ENDMIX = T_RNN + SZ512;
constexpr size_t T_K = WS_BUFA;
constexpr size_t T_V = T_XR;
constexpr size_t T_ATT = T_CQ;
constexpr size_t T_ACT = WS_T;
static_assert(T_ENDMIX <= WS_HB, "mixer temporaries fit");
static_assert(T_ACT + (size_t)272 * 256 * DFE * 2 <= WS_HB && T_ACT + (size_t)MP * DFF * 2 <= WS_HB && WS_HB + (size_t)MP * DM * 2 <= WS_END, "FFN activations + residual fit");
constexpr size_t D_Q = 0, D_AB = (size_t)MP * 768 * 2;
static_assert(D_AB + (size_t)MP * 512 * 4 <= (size_t)MR * DM * 4, "d_out scratch");
constexpr size_t W_IN = 0, SZ_IN = (size_t)NPROJ * DM * 2;
constexpr size_t W_UQ = W_IN + SZ_IN, SZ_UQ = (size_t)768 * QL * 2;
constexpr size_t W_UKV = W_UQ + SZ_UQ, SZ_UKV = (size_t)1024 * KVL * 2;
constexpr size_t W_G = W_UKV + SZ_UKV, SZ_G = (size_t)1024 * 256 * 2;
constexpr size_t W_OUT = W_G + SZ_G, SZ_OUT = (size_t)DM * DM * 2;
constexpr size_t W_LAYER = W_OUT + SZ_OUT;
constexpr size_t W_DENSE = 4 * W_LAYER, SZ_UP = (size_t)2 * DFF * DM * 2, SZ_DN = (size_t)DM * DFF * 2, W_DENSE_STRIDE = SZ_UP + SZ_DN;
constexpr size_t W_MOE = W_DENSE + 2 * W_DENSE_STRIDE, SZ_MUP = (size_t)2 * DFE * DM * 2, SZ_MDN = (size_t)DM * DFE * 2;
constexpr int DFE8 = 1536;
constexpr size_t SZ_MDN8 = (size_t)DM * DFE8;
constexpr size_t SZ_MUP8 = (size_t)2 * DFE * DM;
constexpr size_t SZ_DN8 = (size_t)DM * DFF;
constexpr size_t W_MOE_DN = W_MOE + NE * SZ_MUP, W_END = W_MOE_DN + NE * SZ_MDN;
static_assert(WS_W + W_END <= WS_BUFA, "weights fit");
static_assert(NE * SZ_MUP8 + 2 * SZ_DN8 <= NE * SZ_MUP, "fp8 expert up weights + fp8 dense down weights share the (bf16-sized) MoE up-weight region");
constexpr int CW_TMO = 0, CW_BAR = 4096, CW_MOE = 16384;

constexpr int RING_BYTES = 131072, LDSCTL_OFF = RING_BYTES, MISC_OFF = LDSCTL_OFF + 320, LDS_BYTES = 147456;

#define RLX_AGENT __ATOMIC_RELAXED, __HIP_MEMORY_SCOPE_AGENT
#define LDS_WAIT() asm volatile("s_waitcnt lgkmcnt(0)" ::: "memory")
#define VM_WAIT() asm volatile("s_waitcnt vmcnt(0)" ::: "memory")
__device__ __forceinline__ unsigned f2bf(float f) { unsigned u = __builtin_bit_cast(unsigned, f); return (u + 0x7fffu + ((u >> 16) & 1u)) >> 16; }
__device__ __forceinline__ unsigned pk2(float lo, float hi) { return f2bf(lo) | (f2bf(hi) << 16); }
__device__ __forceinline__ unsigned pk4_fp8(float a, float b, float c, float d) { int r = __builtin_amdgcn_cvt_pk_fp8_f32(a, b, 0, false); r = __builtin_amdgcn_cvt_pk_fp8_f32(c, d, r, true); return (unsigned)r; }
__device__ __forceinline__ float bflo(unsigned w) { return __builtin_bit_cast(float, w << 16); }
__device__ __forceinline__ float bfhi(unsigned w) { return __builtin_bit_cast(float, w & 0xffff0000u); }
__device__ __forceinline__ float bf2f(bf16_t h) { return __builtin_bit_cast(float, (unsigned)h << 16); }
__device__ __forceinline__ float shfl_xor_(float v, int mask, int lane) {
    const int x = __builtin_bit_cast(int, v);
    if (mask == 1) return __builtin_bit_cast(float, __builtin_amdgcn_update_dpp(0, x, 0xB1, 0xF, 0xF, true));
    if (mask == 2) return __builtin_bit_cast(float, __builtin_amdgcn_update_dpp(0, x, 0x4E, 0xF, 0xF, true));
    if (mask == 4) { int t = __builtin_amdgcn_update_dpp(x, x, 0x104, 0xF, 0x5, false); t = __builtin_amdgcn_update_dpp(t, x, 0x114, 0xF, 0xA, false); return __builtin_bit_cast(float, t); }
    if (mask == 8) return __builtin_bit_cast(float, __builtin_amdgcn_update_dpp(0, x, 0x128, 0xF, 0xF, true));
    if (mask == 16) { const auto r = __builtin_amdgcn_permlane16_swap((unsigned)x, (unsigned)x, false, false); return __builtin_bit_cast(float, (lane & 16) ? r[0] : r[1]); }
    const auto r = __builtin_amdgcn_permlane32_swap((unsigned)x, (unsigned)x, false, false); return __builtin_bit_cast(float, (lane & 32) ? r[0] : r[1]);
}
__device__ __forceinline__ float wave_sum(float v, int lane) {
#pragma unroll
    for (int o = 1; o < 64; o <<= 1) v += shfl_xor_(v, o, lane);
    return v;
}
__device__ __forceinline__ float sigmoidf_(float x) { return __builtin_amdgcn_rcpf(1.0f + __builtin_amdgcn_exp2f(-1.4426950408889634f * x)); }
__device__ __forceinline__ float siluf_(float x) { return x * __builtin_amdgcn_rcpf(1.0f + __builtin_amdgcn_exp2f(-1.4426950408889634f * x)); }
__device__ __forceinline__ float gelu_tanhf_(float x) { const float z = 0.7978845608028654f * (x + 0.044715f * x * x * x); return x * __builtin_amdgcn_rcpf(1.0f + __builtin_amdgcn_exp2f(-2.8853900817779268f * z)); }

__device__ __forceinline__ void glds16(const char* sbase, unsigned voff, unsigned lds_dst) { unsigned keep;
    asm volatile("s_mov_b32 %0, m0\n\ts_mov_b32 m0, %3\n\ts_nop 0\n\tglobal_load_lds_dwordx4 %1, %2\n\ts_mov_b32 m0, %0" : "=&s"(keep) : "v"(voff), "s"(sbase), "s"(lds_dst) : "memory"); }
namespace pg8 {
constexpr int BM = 256, BK = 64, HALF = 128, HTB = HALF * BK * 2, NXCD = 8, WGM = 8;
__host__ __device__ __forceinline__ int lds_byte(int r, int c) { const int st = (r >> 4) * 2 + (c >> 5), rr = r & 15, cc = c & 31, ob = rr * 64 + cc * 2; return st * 1024 + (ob ^ (((ob >> 9) & 1) << 5)); }
__host__ __device__ __forceinline__ void stage_rc(int b, int& R, int& C) { const int st = b / 1024, sb = b % 1024, swz = sb ^ (((sb >> 9) & 1) << 5); R = (st >> 1) * 16 + swz / 64; C = (st & 1) * 32 + (swz % 64) / 2; }
__host__ __device__ __forceinline__ int perm32(int rho) { const int n = rho >> 4, i = rho & 15; return 8 * (i >> 2) + 4 * n + (i & 3); }

struct Unit { int pm, pn; unsigned aoff, boff; int grp, prow; };
struct Gemm { const bf16_t* A; const bf16_t* Bt; int lda, ldb, K; };

struct StaticOrder {
    static constexpr bool THIN_META = true;
    int nM, nN, nwg, G, c;
    __device__ void init(int nM_, int nN_, int G_, int c_) { nM = nM_; nN = nN_; nwg = nM * nN; G = G_; c = c_; }
    __device__ bool next(int i, Unit& u) const {
        const long L = (long)i * G + c; if (L >= nwg) return false;
        int wgid = (int)L; { const int q = nwg / NXCD, r = nwg % NXCD, xcd = wgid % NXCD, off = wgid / NXCD; wgid = (xcd < r ? xcd * (q + 1) : r * (q + 1) + (xcd - r) * q) + off; }
        const int nig = WGM * nN, gid = wgid / nig, fm = gid * WGM, gsz = (nM - fm) < WGM ? (nM - fm) : WGM;
        u.pm = fm + ((wgid % nig) % gsz); u.pn = (wgid % nig) / gsz; u.aoff = 0; u.boff = 0; u.grp = 0; u.prow = 0; return true;
    }
    __device__ __forceinline__ int arow(const Unit&, int) const { return 0; }
};

__device__ __forceinline__ const char* uptr(const char* p) {
    const unsigned long long v = (unsigned long long)p; const unsigned lo = __builtin_amdgcn_readfirstlane((unsigned)v), hi = __builtin_amdgcn_readfirstlane((unsigned)(v >> 32));
    return (const char*)(((unsigned long long)hi << 32) | lo); }
typedef int v8i __attribute__((ext_vector_type(8)));
typedef int v4i __attribute__((ext_vector_type(4)));
__device__ __forceinline__ v8i fp8cat(const bf16x8 a, const bf16x8 b) { return __builtin_shufflevector(__builtin_bit_cast(v4i, a), __builtin_bit_cast(v4i, b), 0, 1, 2, 3, 4, 5, 6, 7); }
__device__ __forceinline__ unsigned cvt_pk_bf16(float lo, float hi) { unsigned r; asm volatile("v_cvt_pk_bf16_f32 %0, %1, %2" : "=v"(r) : "v"(lo), "v"(hi)); return r; }

template <class T, class = void> struct epi_caches_rows : std::false_type {};
template <class T> struct epi_caches_rows<T, std::void_t<decltype(T::CACHE_ROWS)>> : std::true_type {};
template <class Epi, class Sched, bool GATHER = false, bool FP8 = false>
__device__ __forceinline__ void gemm_phase(LAS unsigned char* lds, const Gemm g, const Sched& S, const Epi& E, int tid_) {
    asm volatile("" : "+v"(tid_));
    const int tid = tid_, wid = __builtin_amdgcn_readfirstlane(tid >> 6), lane = tid & 63, wr = wid >> 2, wc = wid & 3, fr = lane & 15, fq = lane >> 4;
    const int K = g.K, nt = K / BK;
    unsigned voffB[2], vC[2][2], vN[2][2]; int sR[2], sC[2];
    const size_t kstep = (size_t)(BK * 2);
    const size_t hstepA = (size_t)HALF * g.lda * 2, tstepA = 2 * hstepA, hstepB = (size_t)HALF * g.ldb * 2, tstepB = 2 * hstepB;
#pragma unroll
    for (int i = 0; i < 2; ++i) { int R, C; stage_rc(tid * 16 + i * 8192, R, C); const int Rb = Epi::PERM ? ((R & ~31) + perm32(R & 31)) : R; sR[i] = R; sC[i] = C;
        voffB[i] = (unsigned)(Rb * g.ldb + C) * 2u;
        if (!GATHER) { vC[0][i] = (unsigned)(R * g.lda + C) * 2u; vC[1][i] = vC[0][i]; vN[0][i] = vC[0][i]; vN[1][i] = vC[0][i]; } }
    const unsigned ldsw = (unsigned)wid * 1024u, lds0 = (unsigned)(uintptr_t)lds;
    const int aoff = lds_byte(wr * 64 + fr, fq * 8), boff = lds_byte(wc * 32 + fr, fq * 8);
#define PG8_SA(b, h) (((b) * 2 + (h)) * HTB)
#define PG8_SB(b, h) ((4 + (b) * 2 + (h)) * HTB)
#define PG8_STAGE(bufoff, gbase, voff) do { const char* _gb = uptr((const char*)(gbase)); const unsigned _ld = (unsigned)__builtin_amdgcn_readfirstlane((int)(lds0 + (bufoff) + ldsw)); \
        glds16(_gb, (voff)[0], _ld); glds16(_gb, (voff)[1], _ld + 8192u); } while (0)
#define PG8_STAGE_A(bufoff, gbase, v0, v1) do { const char* _gb = uptr((const char*)(gbase) + ((!GATHER && ((bufoff) / HTB) % 2 == 1) ? hstepA : 0)); const unsigned _ld = (unsigned)__builtin_amdgcn_readfirstlane((int)(lds0 + (bufoff) + ldsw)); \
        glds16(_gb, (v0), _ld); glds16(_gb, (v1), _ld + 8192u); } while (0)
#define PG8_LDA(dst, b, h) do { if (FP8) { _Pragma("unroll") for (int m = 0; m < 4; ++m) dst##8[m] = fp8cat(*(const LAS bf16x8*)(lds + PG8_SA(b, h) + aoff + m * 2048), *(const LAS bf16x8*)(lds + PG8_SA(b, h) + aoff + m * 2048 + 1024)); } \
        else { _Pragma("unroll") for (int m = 0; m < 4; ++m) _Pragma("unroll") for (int k = 0; k < 2; ++k) dst[m][k] = *(const LAS bf16x8*)(lds + PG8_SA(b, h) + aoff + m * 2048 + k * 1024); } } while (0)
#define PG8_LDB(dst, b, h) do { if (FP8) { _Pragma("unroll") for (int n = 0; n < 2; ++n) dst##8[n] = fp8cat(*(const LAS bf16x8*)(lds + PG8_SB(b, h) + boff + n * 2048), *(const LAS bf16x8*)(lds + PG8_SB(b, h) + boff + n * 2048 + 1024)); } \
        else { _Pragma("unroll") for (int n = 0; n < 2; ++n) _Pragma("unroll") for (int k = 0; k < 2; ++k) dst[n][k] = *(const LAS bf16x8*)(lds + PG8_SB(b, h) + boff + n * 2048 + k * 1024); } } while (0)
#define PG8_MMA(ai, bj, At, Bt, Z) do { __builtin_amdgcn_s_setprio(1); \
        if (Z) {        \
            if (FP8) { _Pragma("unroll") for (int m = 0; m < 4; ++m) _Pragma("unroll") for (int n = 0; n < 2; ++n) \
                asm volatile("v_mfma_scale_f32_16x16x128_f8f6f4 %0, %1, %2, 0, %3, %3 op_sel_hi:[0,0,0]" : "=&v"(acc[ai][bj][m][n]) : "v"(Bt##8[n]), "v"(At##8[m]), "v"(sc8)); } \
            else { _Pragma("unroll") for (int m = 0; m < 4; ++m) _Pragma("unroll") for (int n = 0; n < 2; ++n) { \
                acc[ai][bj][m][n] = __builtin_amdgcn_mfma_f32_16x16x32_bf16(Bt[n][0], At[m][0], (f32x4){0.f, 0.f, 0.f, 0.f}, 0, 0, 0); acc[ai][bj][m][n] = __builtin_amdgcn_mfma_f32_16x16x32_bf16(Bt[n][1], At[m][1], acc[ai][bj][m][n], 0, 0, 0); } } \
        } else if (FP8) { _Pragma("unroll") for (int m = 0; m < 4; ++m) _Pragma("unroll") for (int n = 0; n < 2; ++n) \
            asm volatile("v_mfma_scale_f32_16x16x128_f8f6f4 %0, %1, %2, %0, %3, %3 op_sel_hi:[0,0,0]" : "+v"(acc[ai][bj][m][n]) : "v"(Bt##8[n]), "v"(At##8[m]), "v"(sc8)); } \
        else { _Pragma("unroll") for (int m = 0; m < 4; ++m) _Pragma("unroll") for (int n = 0; n < 2; ++n) _Pragma("unroll") for (int k = 0; k < 2; ++k) \
            acc[ai][bj][m][n] = __builtin_amdgcn_mfma_f32_16x16x32_bf16(Bt[n][k], At[m][k], acc[ai][bj][m][n], 0, 0, 0); } __builtin_amdgcn_s_setprio(0); } while (0)
#define PG8_MMA_THIN(ai, bj, At, Bt, Z) do { if ((ai) == 0 && wr == 0) { _Pragma("unroll") for (int n = 0; n < 2; ++n) _Pragma("unroll") for (int k = 0; k < 2; ++k) \
        acc[0][bj][0][n] = __builtin_amdgcn_mfma_f32_16x16x32_bf16(Bt[n][k], At[0][k], acc[0][bj][0][n], 0, 0, 0); } } while (0)
#define PG8_WAIT_V(n) asm volatile("s_waitcnt vmcnt(" #n ")" ::: "memory")
#define PG8_WAIT_L(n) asm volatile("s_waitcnt lgkmcnt(" #n ")" ::: "memory")
#define PG8_BAR __builtin_amdgcn_s_barrier()
#define PG8_SCHED __builtin_amdgcn_sched_barrier(0)
#define PG8_GOFF(v, u) do { if (GATHER) { _Pragma("unroll") for (int _h = 0; _h < 2; ++_h) _Pragma("unroll") for (int _i = 0; _i < 2; ++_i) \
        v[_h][_i] = (unsigned)(S.arow(u, _h * HALF + sR[_i]) * g.lda + sC[_i]) * 2u; } } while (0)
#define PG8_TBODY(MMA_, ZF) { \
            const bool last = (t == nt - 2); constexpr bool zf = ZF; \
            const char* a1 = cA + (size_t)(t + 1) * kstep; \
            const char* a2 = last ? nA : cA + (size_t)(t + 2) * kstep; const char* b2 = last ? nB : cB + (size_t)(t + 2) * kstep; \
            const char* a3 = a2 + kstep; const char* b3 = b2 + kstep; \
            const unsigned x00 = (GATHER && last) ? vN[0][0] : vC[0][0], x01 = (GATHER && last) ? vN[0][1] : vC[0][1], x10 = (GATHER && last) ? vN[1][0] : vC[1][0], x11 = (GATHER && last) ? vN[1][1] : vC[1][1]; \
            PG8_LDB(B0, 0, 0); PG8_LDB(B1, 0, 1); PG8_SCHED; PG8_LDA(At, 0, 0); PG8_STAGE_A(PG8_SA(1, 1), a1, vC[1][0], vC[1][1]); \
            PG8_WAIT_V(8); PG8_WAIT_L(0); PG8_BAR; MMA_(0, 0, At, B0, zf); MMA_(0, 1, At, B1, zf); PG8_BAR; PG8_SCHED; \
            PG8_LDA(At, 0, 1); PG8_STAGE(PG8_SB(0, 0), b2, voffB); PG8_STAGE(PG8_SB(0, 1), b2 + hstepB, voffB); PG8_STAGE_A(PG8_SA(0, 0), a2, x00, x01); \
            PG8_WAIT_V(8); PG8_WAIT_L(0); PG8_BAR; MMA_(1, 0, At, B0, zf); MMA_(1, 1, At, B1, zf); PG8_BAR; PG8_SCHED; \
            PG8_LDB(B0, 1, 0); PG8_LDB(B1, 1, 1); PG8_SCHED; PG8_LDA(At, 1, 0); PG8_STAGE_A(PG8_SA(0, 1), a2, x10, x11); \
            PG8_WAIT_V(8); PG8_WAIT_L(0); PG8_BAR; MMA_(0, 0, At, B0, false); MMA_(0, 1, At, B1, false); PG8_BAR; PG8_SCHED; \
            PG8_LDA(At, 1, 1); PG8_STAGE(PG8_SB(1, 0), b3, voffB); PG8_STAGE(PG8_SB(1, 1), b3 + hstepB, voffB); PG8_STAGE_A(PG8_SA(1, 0), a3, x00, x01); \
            PG8_WAIT_V(8); PG8_WAIT_L(0); PG8_BAR; MMA_(1, 0, At, B0, false); MMA_(1, 1, At, B1, false); PG8_BAR; PG8_SCHED; \
        }
#define PG8_UNI(u) do { u.pm = __builtin_amdgcn_readfirstlane(u.pm); u.pn = __builtin_amdgcn_readfirstlane(u.pn); u.aoff = __builtin_amdgcn_readfirstlane(u.aoff); u.boff = __builtin_amdgcn_readfirstlane(u.boff); \
        u.grp = __builtin_amdgcn_readfirstlane(u.grp); u.prow = __builtin_amdgcn_readfirstlane(u.prow); } while (0)
    Unit cur, nxt; int ui = 0; float rcache[16]; int rcache_pm = -1; (void)rcache; (void)rcache_pm;
    if (!S.next(0, cur)) return;
    PG8_UNI(cur);
    constexpr bool ZC = FP8 && !Sched::THIN_META;
    f32x4 acc[2][2][4][2];
    if (!ZC)
#pragma unroll
    for (int a = 0; a < 2; ++a)
#pragma unroll
        for (int b = 0; b < 2; ++b)
#pragma unroll
            for (int m = 0; m < 4; ++m)
#pragma unroll
                for (int n = 0; n < 2; ++n) acc[a][b][m][n] = (f32x4){0.f, 0.f, 0.f, 0.f};
    const int sc8 = 0x7F7F7F7F;
    bf16x8 At[4][2], B0[2][2], B1[2][2]; v8i At8[4], B08[2], B18[2];
    const char* cA = (const char*)g.A + (GATHER ? (size_t)0 : (size_t)cur.pm * tstepA) + cur.aoff; const char* cB = (const char*)g.Bt + (size_t)cur.pn * tstepB + cur.boff;
    PG8_GOFF(vC, cur);
    PG8_STAGE(PG8_SB(0, 0), cB, voffB); PG8_STAGE(PG8_SB(0, 1), cB + hstepB, voffB); PG8_STAGE_A(PG8_SA(0, 0), cA, vC[0][0], vC[0][1]); PG8_STAGE_A(PG8_SA(0, 1), cA, vC[1][0], vC[1][1]);
    if (wr == 1) PG8_BAR;
    PG8_WAIT_V(2); PG8_BAR;
    PG8_STAGE(PG8_SB(1, 0), cB + kstep, voffB); PG8_STAGE_A(PG8_SA(1, 0), cA + kstep, vC[0][0], vC[0][1]); PG8_STAGE(PG8_SB(1, 1), cB + hstepB + kstep, voffB);
    PG8_WAIT_V(6); PG8_BAR;
    for (;;) {
        const bool has_next = S.next(ui + 1, nxt);
        PG8_UNI(nxt);
        const char* nA = has_next ? (const char*)g.A + (GATHER ? (size_t)0 : (size_t)nxt.pm * tstepA) + nxt.aoff : cA; const char* nB = has_next ? (const char*)g.Bt + (size_t)nxt.pn * tstepB + nxt.boff : cB;
        if (GATHER) { if (has_next) { PG8_GOFF(vN, nxt); } else {
#pragma unroll
            for (int _h = 0; _h < 2; ++_h)
#pragma unroll
                for (int _i = 0; _i < 2; ++_i) vN[_h][_i] = vC[_h][_i]; } }
        const bool thin = Sched::THIN_META && cur.pm == MR / 256;
        if (thin) { _Pragma("unroll 1") for (int t = 0; t < nt; t += 2) PG8_TBODY(PG8_MMA_THIN, false) }
        else if (ZC) { { const int t = 0; PG8_TBODY(PG8_MMA, true) }
            _Pragma("unroll 1") for (int t = 2; t < nt; t += 2) PG8_TBODY(PG8_MMA, false) }
        else { _Pragma("unroll 1") for (int t = 0; t < nt; t += 2) PG8_TBODY(PG8_MMA, false) }
        if (FP8) asm volatile("s_nop 15\n\ts_nop 15" ::: "memory");
        if (wr == 0) PG8_BAR;
        { int ln_; asm volatile("v_mbcnt_lo_u32_b32 %0, -1, 0\n\tv_mbcnt_hi_u32_b32 %0, -1, %0" : "=v"(ln_)); if constexpr (epi_caches_rows<Epi>::value) E(acc, cur, S, wr, wc, ln_ & 15, ln_ >> 4, rcache, rcache_pm); else E(acc, cur, S, wr, wc, ln_ & 15, ln_ >> 4); }
        if (!has_next) break;
        if (!ZC)
#pragma unroll
        for (int a = 0; a < 2; ++a)
#pragma unroll
            for (int b = 0; b < 2; ++b)
#pragma unroll
                for (int m = 0; m < 4; ++m)
#pragma unroll
                    for (int n = 0; n < 2; ++n) acc[a][b][m][n] = (f32x4){0.f, 0.f, 0.f, 0.f};
        cur = nxt; cA = nA; cB = nB; ++ui;
#pragma unroll
        for (int _h = 0; _h < 2; ++_h)
#pragma unroll
            for (int _i = 0; _i < 2; ++_i) vC[_h][_i] = vN[_h][_i];
        if (wr == 1) PG8_BAR;
    }
    PG8_WAIT_V(0);
    PG8_BAR;
#undef PG8_SA
#undef PG8_SB
#undef PG8_STAGE
#undef PG8_STAGE_A
#undef PG8_LDA
#undef PG8_LDB
#undef PG8_MMA
#undef PG8_MMA_THIN
#undef PG8_TBODY
#undef PG8_WAIT_V
#undef PG8_WAIT_L
#undef PG8_BAR
#undef PG8_SCHED
#undef PG8_GOFF
#undef PG8_UNI
}
}

#define XB_TMO      128
#define XB_XCNT(j)  (256  + 64 * (j))
#define XB_XSUB(j)  (1280 + 64 * (j))
#define XB_XGEN(j)  (2304 + 64 * (j))
#define XB_TOP      3328
#define XB_TOPGEN   3392
#define XCD_BAR_WORDS 3456
#define XB_SPIN_CAP (1u << 18)
__device__ __forceinline__ unsigned xb_ld(unsigned* p)              { return __hip_atomic_load(p, __ATOMIC_RELAXED, __HIP_MEMORY_SCOPE_AGENT); }
__device__ __forceinline__ unsigned xb_add(unsigned* p, unsigned v) { return __hip_atomic_fetch_add(p, v, __ATOMIC_RELAXED, __HIP_MEMORY_SCOPE_AGENT); }
__device__ __forceinline__ unsigned xb_xcc_id() { return (unsigned)__builtin_amdgcn_s_getreg((3 << 11) | 20) & 0xFu; }
#define XB_SPIN(cond, bar) do { unsigned _sp = 0; while (cond) { __builtin_amdgcn_s_sleep(1); \
    if ((++_sp & 255u) == 0u) { if (xb_ld(&(bar)[XB_TMO])) break; if (_sp > XB_SPIN_CAP) { atomicAdd(&(bar)[XB_TMO], 1u); break; } } } } while (0)
struct XcdBarrier { unsigned* bar; unsigned x; volatile LAS unsigned* st; };
__device__ __forceinline__ bool xb_is_t0(int wave_s) { return wave_s == 0 && __builtin_amdgcn_mbcnt_hi(~0u, __builtin_amdgcn_mbcnt_lo(~0u, 0u)) == 0u; }
__device__ __forceinline__ XcdBarrier xcd_barrier_post(unsigned* bar, volatile LAS unsigned* st, int wave_s) {
    XcdBarrier b; b.bar = bar; b.x = xb_xcc_id(); b.st = st;
    if (xb_is_t0(wave_s)) (void)xb_add(&bar[XB_XCNT(b.x)], 1u);
    return b;
}
__device__ __forceinline__ void xcd_barrier_complete(unsigned* bar, unsigned x, unsigned& nloc, unsigned& nx) {
    const unsigned G = gridDim.x * gridDim.y * gridDim.z;
    unsigned sum, cnt, mine, sp = 0u;
    for (;;) {
        sum = 0u; cnt = 0u; mine = 0u;
#pragma unroll
        for (unsigned j = 0; j < 16; ++j) { const unsigned c = xb_ld(&bar[XB_XCNT(j)]); sum += c; cnt += (c > 0u) ? 1u : 0u; mine = (j == x) ? c : mine; }
        if (sum == G) break;
        __builtin_amdgcn_s_sleep(1);
        if ((++sp & 255u) == 0u) { if (xb_ld(&bar[XB_TMO])) break; if (sp > XB_SPIN_CAP) { atomicAdd(&bar[XB_TMO], 1u); break; } }
    }
    nloc = mine > 0u ? mine : 1u; nx = cnt > 0u ? cnt : 1u;
}
__device__ __forceinline__ void xcd_barrier(const XcdBarrier& b, int wave_s) {
    asm volatile("s_waitcnt vmcnt(0)" ::: "memory");
    __syncthreads();
    if (xb_is_t0(wave_s)) {
        unsigned* bar = b.bar; asm volatile("" : "+s"(bar));
        __builtin_amdgcn_s_waitcnt(0);
        unsigned nloc = b.st[0], nx = b.st[1];
        if (nloc == 0u) { xcd_barrier_complete(bar, b.x, nloc, nx); b.st[0] = nloc; b.st[1] = nx; }
        const unsigned old = xb_add(&bar[XB_XSUB(b.x)], 1u);
        const unsigned gen = old / nloc;
        if (old + 1u == (gen + 1u) * nloc) {
            __builtin_amdgcn_fence(__ATOMIC_RELEASE, "agent");
            asm volatile("s_waitcnt vmcnt(0)" ::: "memory");
            const unsigned og = xb_add(&bar[XB_TOP], 1u);
            const unsigned tg = og / nx;
            if (og + 1u == (tg + 1u) * nx) xb_add(&bar[XB_TOPGEN], 1u);
            else XB_SPIN(xb_ld(&bar[XB_TOPGEN]) == tg, bar);
            __builtin_amdgcn_fence(__ATOMIC_ACQUIRE, "agent");
            xb_add(&bar[XB_XGEN(b.x)], 1u);
            asm volatile("s_waitcnt vmcnt(0)" ::: "memory");
        } else {
            XB_SPIN(xb_ld(&bar[XB_XGEN(b.x)]) == gen, bar);
            __builtin_amdgcn_fence(__ATOMIC_ACQUIRE, "agent");
            asm volatile("s_waitcnt vmcnt(0)" ::: "memory");
        }
    }
    __syncthreads();
}

#define CAS __attribute__((address_space(4)))
struct Frame {
    LAS unsigned char* lds;
    volatile LAS unsigned* MISC;
    gu32* ctl;
    int tid, lane, wave, G, vcu;
    const CAS unsigned char* ka;
    unsigned char* ws;
    float* out;
    bf16_t* hb;
    __device__ __forceinline__ const void* in(int i) const { return ((const void* const CAS*)ka)[i]; }
};
struct Args { const void* in[29]; float* out; unsigned char* ws; int pad0, pad1; };
__device__ __forceinline__ Frame mkframe(unsigned char* lds_raw, int wave_s) {
    Frame F; int lane_; asm volatile("v_mbcnt_lo_u32_b32 %0, -1, 0\n\tv_mbcnt_hi_u32_b32 %0, -1, %0" : "=v"(lane_));
    int tid = wave_s * 64 + lane_;
    const CAS unsigned char* ka = (const CAS unsigned char*)__builtin_amdgcn_kernarg_segment_ptr(); asm volatile("" : "+s"(ka));
    F.ka = ka; F.lds = (LAS unsigned char*)lds_raw; F.MISC = (volatile LAS unsigned*)(F.lds + MISC_OFF);
    F.tid = tid; F.lane = tid & 63; F.wave = __builtin_amdgcn_readfirstlane(tid >> 6);
    int G = gridDim.x; asm volatile("" : "+s"(G)); F.G = G; { const int bx = blockIdx.x; F.vcu = (G % 8 == 0) ? (bx % 8) * (G / 8) + bx / 8 : bx; }
    F.out = *(float* const CAS*)(ka + 232); F.ws = *(unsigned char* const CAS*)(ka + 240);
    F.hb = (bf16_t*)(F.ws + WS_HB); F.ctl = (gu32*)(F.ws + WS_CTL);
    return F;
}
enum { I_X = 0, I_POS, I_META, I_NORM_MIX_G, I_W_IN, I_Q_NORM_G, I_W_UQ, I_KV_NORM_G, I_W_UKV, I_Q_HEAD_G, I_K_HEAD_G, I_CONV_W, I_CONV_B, I_W_A, I_B_A, I_W_I, I_B_I, I_LAMBDA,
       I_ATT_G, I_RNN_G, I_W_OUT, I_NORM_FFN_G, I_FFN_GATE, I_FFN_UP, I_FFN_DOWN, I_ROUTER, I_MOE_GATE, I_MOE_UP, I_MOE_DOWN };


__device__ __forceinline__ void tr_item(const float* W, int ldw, int k0, int n0, bf16_t* WT, int ldk, int drow0, const float* gain, LAS float* scr, int lane, unsigned char* W8 = nullptr, bool only8 = false) {
    { const int lr = lane >> 3, lc = (lane & 7) * 4; f32x4 v[8]; float gn[8];
#pragma unroll
      for (int i = 0; i < 8; ++i) { const int kk = 8 * i + lr; v[i] = *(const GAS f32x4*)(W + (size_t)(k0 + kk) * ldw + n0 + lc); gn[i] = gain ? gain[k0 + kk] : 1.f; }
#pragma unroll
      for (int i = 0; i < 8; ++i) { LAS float* d = scr + (8 * i + lr) * 33 + lc; d[0] = v[i][0] * gn[i]; d[1] = v[i][1] * gn[i]; d[2] = v[i][2] * gn[i]; d[3] = v[i][3] * gn[i]; } }
    LDS_WAIT(); asm volatile("" ::: "memory");
    const int c = lane & 7;
#pragma unroll
    for (int j = 0; j < 4; ++j) { const int n = (lane >> 3) + 8 * j; const LAS float* s = scr + (8 * c) * 33 + n;
        u32x4 o; o.x = pk2(s[0 * 33], s[1 * 33]); o.y = pk2(s[2 * 33], s[3 * 33]); o.z = pk2(s[4 * 33], s[5 * 33]); o.w = pk2(s[6 * 33], s[7 * 33]);
        if (!only8) *(GAS u32x4*)(WT + (size_t)(drow0 + n) * ldk + k0 + 8 * c) = o;
        if (W8) *(GAS u32x2*)(W8 + (size_t)(drow0 + n) * ldk + k0 + 8 * c) = (u32x2){pk4_fp8(64.f * s[0 * 33], 64.f * s[1 * 33], 64.f * s[2 * 33], 64.f * s[3 * 33]), pk4_fp8(64.f * s[4 * 33], 64.f * s[5 * 33], 64.f * s[6 * 33], 64.f * s[7 * 33])}; }
    LDS_WAIT(); asm volatile("" ::: "memory");
}
__device__ __forceinline__ int tr_map(int mode, int n) {
    if (mode == 0) return n;
    if (mode == 1) return n < 384 ? n : (n < 640 ? n + 128 : (n < 672 ? n - 256 : n + 96));
    if (mode == 4) { const int h = n >> 7, d = n & 127; return d < 64 ? 256 * (h >> 2) + 128 * (d >> 5) + 32 * (h & 3) + (d & 31) : 512 + 64 * h + (d - 64); }
    return 256 * (n >> 7) + (n & 127) + (mode == 3 ? 128 : 0);
}
__device__ __forceinline__ void tr_job(const float* W, int K, int N, bf16_t* WT, const float* gain, int mode, int item, LAS float* scr, int lane, unsigned char* W8 = nullptr, bool only8 = false, int ldk8 = 0) {
    const int nblk = N / 32, kb = item / nblk, nb = item % nblk;
    tr_item(W, N, 64 * kb, 32 * nb, WT, ldk8 ? ldk8 : K, tr_map(mode, 32 * nb), gain, scr, lane, W8, only8);
}
constexpr int IT_IN = (DM / 64) * (DIN / 32), IT_UQ = (QL / 64) * (768 / 32), IT_UKV = (KVL / 64) * (1024 / 32), IT_OUT = (DM / 64) * (DM / 32), IT_MIX = IT_IN + IT_UQ + IT_UKV + IT_OUT;
constexpr int IT_DG = (DM / 64) * (DFF / 32), IT_DD = (DFF / 64) * (DM / 32), IT_DENSE = 2 * IT_DG + IT_DD;
constexpr int IT_MG = (DM / 64) * (DFE / 32), IT_MD = (DFE / 64) * (DM / 32), IT_EXP = 2 * IT_MG + IT_MD;
constexpr int JIT_SPLIT = 11264;

__device__ __forceinline__ void conv_mixer_dense_weights(const Frame& F) {
    LAS float* scr = (LAS float*)(F.lds + F.wave * 16384);
    const int gw = F.vcu * NWAVES + F.wave, NGW = F.G * NWAVES;
    unsigned char* wb = F.ws + WS_W;
    for (int it = gw; it < 4 * IT_MIX + 2 * IT_DENSE; it += NGW) {
        if (it < 4 * IT_MIX) {
            const int l = it / IT_MIX; int r = it % IT_MIX; unsigned char* lb = wb + (size_t)l * W_LAYER;
            if (r < IT_IN) { tr_job((const float*)F.in(I_W_IN) + (size_t)l * DM * DIN, DM, DIN, (bf16_t*)(lb + W_IN), (const float*)F.in(I_NORM_MIX_G) + l * DM, 1, r, scr, F.lane); continue; } r -= IT_IN;
            if (r < IT_UQ) { tr_job((const float*)F.in(I_W_UQ) + (size_t)l * QL * 768, QL, 768, (bf16_t*)(lb + W_UQ), (const float*)F.in(I_Q_NORM_G) + l * QL, 0, r, scr, F.lane); continue; } r -= IT_UQ;
            if (r < IT_UKV) { tr_job((const float*)F.in(I_W_UKV) + (size_t)l * KVL * 1024, KVL, 1024, (bf16_t*)(lb + W_UKV), (const float*)F.in(I_KV_NORM_G) + l * KVL, 4, r, scr, F.lane); continue; } r -= IT_UKV;
            {
                const int nblk = DM / 32, kb = r / nblk, nb = r % nblk; const float* gain = kb < 8 ? (const float*)F.in(I_ATT_G) + l * 512 : (const float*)F.in(I_RNN_G) + l * 512 - 512;
                tr_item((const float*)F.in(I_W_OUT) + (size_t)l * DM * DM, DM, 64 * kb, 32 * nb, (bf16_t*)(lb + W_OUT), DM, 32 * nb, gain, scr, F.lane); }
        } else {
            int r = it - 4 * IT_MIX; const int j = r / IT_DENSE; r %= IT_DENSE; unsigned char* db = wb + W_DENSE + (size_t)j * W_DENSE_STRIDE; const float* gain = (const float*)F.in(I_NORM_FFN_G) + (2 * j) * DM;
            if (r < IT_DG) { tr_job((const float*)F.in(I_FFN_GATE) + (size_t)j * DM * DFF, DM, DFF, (bf16_t*)db, gain, 2, r, scr, F.lane, F.ws + WS_W8 + (size_t)j * SZ_W8); continue; } r -= IT_DG;
            if (r < IT_DG) { tr_job((const float*)F.in(I_FFN_UP) + (size_t)j * DM * DFF, DM, DFF, (bf16_t*)db, gain, 3, r, scr, F.lane, F.ws + WS_W8 + (size_t)j * SZ_W8); continue; } r -= IT_DG;
            tr_job((const float*)F.in(I_FFN_DOWN) + (size_t)j * DFF * DM, DFF, DM, (bf16_t*)(db + SZ_UP), nullptr, 0, r, scr, F.lane, wb + W_MOE + NE * SZ_MUP8 + (size_t)j * SZ_DN8);
        }
    }
}
__device__ __forceinline__ void conv_moe_weights(const Frame& F, int j, int it0 = 0, int it1 = NE * IT_EXP, int wgr = -1, int nwg = 0, bool pad = true) {
    LAS float* scr = (LAS float*)(F.lds + F.wave * 16384);
    const int gw = (wgr < 0 ? F.vcu : wgr) * NWAVES + F.wave, NGW = (wgr < 0 ? F.G : nwg) * NWAVES;
    unsigned char* wb = F.ws + WS_W; const float* gain = (const float*)F.in(I_NORM_FFN_G) + (2 * j + 1) * DM;
    for (int it = it0 + gw; it < it1; it += NGW) {
        const int e = it / IT_EXP; int r = it % IT_EXP; const size_t eo = (size_t)(j * NE + e);
        if (r < IT_MG) { tr_job((const float*)F.in(I_MOE_GATE) + eo * DM * DFE, DM, DFE, nullptr, gain, 2, r, scr, F.lane, wb + W_MOE + (size_t)e * SZ_MUP8, true); continue; } r -= IT_MG;
        if (r < IT_MG) { tr_job((const float*)F.in(I_MOE_UP) + eo * DM * DFE, DM, DFE, nullptr, gain, 3, r, scr, F.lane, wb + W_MOE + (size_t)e * SZ_MUP8, true); continue; } r -= IT_MG;
        tr_job((const float*)F.in(I_MOE_DOWN) + eo * DFE * DM, DFE, DM, nullptr, nullptr, 0, r, scr, F.lane, wb + W_MOE_DN + (size_t)e * SZ_MDN8, true, DFE8);
    }
    if (pad) for (int i = F.vcu * NTHREADS + F.tid; i < NE * DM * 8; i += F.G * NTHREADS) *(GAS u32x4*)(wb + W_MOE_DN + (size_t)(i >> 3) * DFE8 + DFE + (i & 7) * 16) = (u32x4){0u, 0u, 0u, 0u};
}
__device__ __forceinline__ void prologue_misc(const Frame& F) {
    const int gt = F.vcu * NTHREADS + F.tid, NGT = F.G * NTHREADS;
    unsigned char* wb = F.ws + WS_W;
    for (int i = gt; i < 4 * 96 * (DM / 8); i += NGT) { const int l = i / (96 * (DM / 8)), r = i % (96 * (DM / 8)); *(GAS u32x4*)(wb + (size_t)l * W_LAYER + W_IN + ((size_t)(416 + r / (DM / 8)) * DM + (r % (DM / 8)) * 8) * 2) = (u32x4){0u, 0u, 0u, 0u}; }
    for (int i0 = gt; i0 < 4 * 4 * 256 * 256; i0 += 8 * NGT) {
        float vv[8];
#pragma unroll
        for (int q = 0; q < 8; ++q) { const int i = i0 + q * NGT; vv[q] = 0.f; if (i < 4 * 4 * 256 * 256) {
            const int kk = i & 255, rr = (i >> 8) & 255, j = (i >> 16) & 3, l = i >> 18;
            const int ch = 128 * j + (rr & 127), blk = ch >> 6, d = ch & 63, cin = 256 * (j >> 1) + kk, blk_in = cin >> 6, c = cin & 63;
            const float* Wsrc = (const float*)F.in(rr < 128 ? I_W_A : I_W_I) + (size_t)l * 8 * 64 * 64;
            if (blk_in == blk) vv[q] = Wsrc[(blk * 64 + c) * 64 + d]; } }
#pragma unroll
        for (int q = 0; q < 8; ++q) { const int i = i0 + q * NGT; if (i < 4 * 4 * 256 * 256) {
            const int kk = i & 255, rr = (i >> 8) & 255, j = (i >> 16) & 3, l = i >> 18;
            ((bf16_t*)(wb + (size_t)l * W_LAYER + W_G))[((size_t)j * 256 + rr) * 256 + kk] = (bf16_t)f2bf(vv[q]); } }
    }
    float* rope = (float*)(F.ws + WS_ROPE);
    for (int i = gt; i < MP * 16; i += NGT) {
        const int row = i >> 4, k = i & 15; int pos = 0;
        if (row < MR) pos = ((const int*)F.in(I_POS))[row] + NMETA; else if (row < MVALID) pos = row - MR;
        const double ang = (double)pos * exp(-(double)k / 16.0 * 9.210340371976184);
        double s, c; sincos(ang, &s, &c);
        rope[(size_t)row * 32 + k] = (float)c; rope[(size_t)row * 32 + 16 + k] = (float)s;
    }
}
__device__ __forceinline__ void phase_x_to_hb(const Frame& F) {
    const int gw = F.vcu * NWAVES + F.wave, NGW = F.G * NWAVES; float* ssq = (float*)(F.ws + WS_SSQ1);
    for (int row0 = 4 * gw; row0 < MP; row0 += 4 * NGW) {
        f32x4 v[4][4];
#pragma unroll
        for (int r = 0; r < 4; ++r) { const int row = row0 + r;
            if (row < MVALID) { const float* xr = row < MR ? (const float*)F.in(I_X) + (size_t)row * DM : (const float*)F.in(I_META) + (size_t)(row - MR) * DM;
#pragma unroll
                for (int j = 0; j < 4; ++j) v[r][j] = ((const GAS f32x4*)xr)[F.lane + 64 * j]; }
            else {
#pragma unroll
                for (int j = 0; j < 4; ++j) v[r][j] = (f32x4){0.f, 0.f, 0.f, 0.f}; } }
#pragma unroll
        for (int r = 0; r < 4; ++r) { const int row = row0 + r; float s = 0.f;
#pragma unroll
            for (int j = 0; j < 4; ++j) s += (v[r][j].x * v[r][j].x + v[r][j].y * v[r][j].y) + (v[r][j].z * v[r][j].z + v[r][j].w * v[r][j].w);
            s = wave_sum(s, F.lane);
            GAS u32x2* o = (GAS u32x2*)(F.hb + (size_t)row * DM);
#pragma unroll
            for (int j = 0; j < 4; ++j) o[F.lane + 64 * j] = (u32x2){pk2(v[r][j].x, v[r][j].y), pk2(v[r][j].z, v[r][j].w)};
            if (F.lane < 16) ssq[(size_t)row * 16 + F.lane] = F.lane == 0 ? s : 0.f; }
    }
}

__device__ __forceinline__ void phase_e1(const Frame& F, int l) {
    const int gw = F.vcu * NWAVES + F.wave, NGW = F.G * NWAVES;
    const bf16_t* XR = (const bf16_t*)(F.ws + T_XR); bf16_t* XC = (bf16_t*)(F.ws + T_XC);
    const float* cw = (const float*)F.in(I_CONV_W) + (size_t)l * 4 * DR; const float* cb = (const float*)F.in(I_CONV_B) + (size_t)l * DR;
    const int ch0 = F.lane * 8; float wt[4][8], bs[8];
    { const f32x4 b0 = *(const GAS f32x4*)(cb + ch0), b1 = *(const GAS f32x4*)(cb + ch0 + 4); bs[0] = b0.x; bs[1] = b0.y; bs[2] = b0.z; bs[3] = b0.w; bs[4] = b1.x; bs[5] = b1.y; bs[6] = b1.z; bs[7] = b1.w; }
#pragma unroll
    for (int j = 0; j < 4; ++j) { const f32x4 w0 = *(const GAS f32x4*)(cw + j * DR + ch0), w1 = *(const GAS f32x4*)(cw + j * DR + ch0 + 4);
        wt[j][0] = w0.x; wt[j][1] = w0.y; wt[j][2] = w0.z; wt[j][3] = w0.w; wt[j][4] = w1.x; wt[j][5] = w1.y; wt[j][6] = w1.z; wt[j][7] = w1.w; }
    for (int g = gw; g < MP / 4; g += NGW) {
        const int row0 = 4 * g;
        const int t0 = row0 < MR ? NMETA + (row0 & (SEQ - 1)) : row0 - MR; const int rb = row0 < MR ? (row0 & ~(SEQ - 1)) : 0;
        u32x4 x[7];
#pragma unroll
        for (int k = 0; k < 7; ++k) { const int tt = t0 - 3 + k; x[k] = (u32x4){0u, 0u, 0u, 0u};
            if (row0 < MVALID && tt >= 0) { const int srow = tt < NMETA ? MR + tt : rb + (tt - NMETA); x[k] = *(const GAS u32x4*)(XR + (size_t)srow * 512 + ch0); } }
#pragma unroll
        for (int r = 0; r < 4; ++r) { float acc[8];
#pragma unroll
            for (int e = 0; e < 8; ++e) acc[e] = row0 < MVALID ? bs[e] : 0.f;
#pragma unroll
            for (int j = 0; j < 4; ++j) { const u32x4 v = x[r + j];
                acc[0] += bflo(v.x) * wt[j][0]; acc[1] += bfhi(v.x) * wt[j][1]; acc[2] += bflo(v.y) * wt[j][2]; acc[3] += bfhi(v.y) * wt[j][3];
                acc[4] += bflo(v.z) * wt[j][4]; acc[5] += bfhi(v.z) * wt[j][5]; acc[6] += bflo(v.w) * wt[j][6]; acc[7] += bfhi(v.w) * wt[j][7]; }
            *(GAS u32x4*)(XC + (size_t)(row0 + r) * 512 + ch0) = (u32x4){pk2(acc[0], acc[1]), pk2(acc[2], acc[3]), pk2(acc[4], acc[5]), pk2(acc[6], acc[7])}; }
    }
}
__device__ __forceinline__ void phase_route(const Frame& F, int jm) {
    const int gw = F.vcu * NWAVES + F.wave, NGW = F.G * NWAVES, lane = F.lane;
    int* list = (int*)(F.ws + WS_LIST); f32x2* wlist = (f32x2*)(F.ws + WS_WLIST);
    const float* g = (const float*)F.in(I_NORM_FFN_G) + (2 * jm + 1) * DM; const float* wr = (const float*)F.in(I_ROUTER) + (size_t)jm * DM * NE;
    LAS f32x4* T = (LAS f32x4*)F.lds; LAS unsigned* rec = (LAS unsigned*)(F.lds + 32768); LAS unsigned* lcnt = (LAS unsigned*)(F.lds + 32768 + 17 * NWAVES * 32); LAS unsigned* gbase = lcnt + 16;
    if (F.tid < 16) lcnt[F.tid] = 0u;
    int nrec = 0;
    for (int idx = F.tid; idx < 2 * 16 * 64; idx += NTHREADS) { const int ln = idx & 63, i = (idx >> 6) & 15, half = idx >> 10, k = 512 * (i >> 3) + 8 * ln + (i & 7);
        const f32x4 w = *(const GAS f32x4*)(wr + (size_t)k * 8 + 4 * half); T[idx] = w * g[k]; }
    __syncthreads();
    u32x4 cur[2] = {(u32x4){0u, 0u, 0u, 0u}, (u32x4){0u, 0u, 0u, 0u}};
    if (gw < MVALID) { cur[0] = *(const GAS u32x4*)(F.hb + (size_t)gw * DM + 8 * lane); cur[1] = *(const GAS u32x4*)(F.hb + (size_t)gw * DM + 512 + 8 * lane); }
    for (int row = gw; row < MVALID; row += NGW) {
        float v[16]; float s = 0.f; u32x4 nxt[2] = {cur[0], cur[1]};
        if (row + NGW < MVALID) { nxt[0] = *(const GAS u32x4*)(F.hb + (size_t)(row + NGW) * DM + 8 * lane); nxt[1] = *(const GAS u32x4*)(F.hb + (size_t)(row + NGW) * DM + 512 + 8 * lane); }
#pragma unroll
        for (int j = 0; j < 2; ++j) { const u32x4 w = cur[j];
            v[8 * j] = bflo(w.x); v[8 * j + 1] = bfhi(w.x); v[8 * j + 2] = bflo(w.y); v[8 * j + 3] = bfhi(w.y); v[8 * j + 4] = bflo(w.z); v[8 * j + 5] = bfhi(w.z); v[8 * j + 6] = bflo(w.w); v[8 * j + 7] = bfhi(w.w); }
        f32x4 la = {0.f, 0.f, 0.f, 0.f}, lb = {0.f, 0.f, 0.f, 0.f};
#pragma unroll
        for (int i = 0; i < 16; ++i) { s += v[i] * v[i]; la += T[i * 64 + lane] * v[i]; lb += T[(16 + i) * 64 + lane] * v[i]; }
        const float rs = __builtin_amdgcn_rsqf(wave_sum(s, lane) * (1.f / DM) + EPS);
        f32x4 keep = (lane & 32) ? lb : la, give = (lane & 32) ? la : lb;
#pragma unroll
        for (int e = 0; e < 4; ++e) keep[e] += shfl_xor_(give[e], 32, lane);
        float k0 = (lane & 16) ? keep[2] : keep[0], k1 = (lane & 16) ? keep[3] : keep[1], g0 = (lane & 16) ? keep[0] : keep[2], g1 = (lane & 16) ? keep[1] : keep[3];
        k0 += shfl_xor_(g0, 16, lane); k1 += shfl_xor_(g1, 16, lane);
        float x = (lane & 8) ? k1 : k0; const float gx = (lane & 8) ? k0 : k1; x += shfl_xor_(gx, 8, lane);
        x += shfl_xor_(x, 4, lane); x += shfl_xor_(x, 2, lane); x += shfl_xor_(x, 1, lane);
        float lg[8];
#pragma unroll
        for (int e = 0; e < 8; ++e) lg[e] = __builtin_bit_cast(float, __builtin_amdgcn_readlane(__builtin_bit_cast(int, x), 8 * e)) * rs;
        int e0 = 0; float v0 = lg[0];
#pragma unroll
        for (int e = 1; e < 8; ++e) if (lg[e] > v0) { v0 = lg[e]; e0 = e; }
        int e1 = -1; float v1 = -3.0e38f;
#pragma unroll
        for (int e = 0; e < 8; ++e) if (e != e0 && lg[e] > v1) { v1 = lg[e]; e1 = e; }
        const float w1 = __builtin_amdgcn_rcpf(1.0f + __expf(v0 - v1)), w0 = 1.0f - w1;
        if (lane == 0) {
            const unsigned p0 = __hip_atomic_fetch_add(lcnt + e0, 1u, __ATOMIC_RELAXED, __HIP_MEMORY_SCOPE_WORKGROUP), p1 = __hip_atomic_fetch_add(lcnt + 8 + e1, 1u, __ATOMIC_RELAXED, __HIP_MEMORY_SCOPE_WORKGROUP);
            LAS unsigned* r = rec + (nrec * NWAVES + F.wave) * 8; r[0] = (unsigned)row; r[1] = (unsigned)e0 | ((unsigned)(8 + e1) << 8); r[2] = p0; r[3] = p1; r[4] = __builtin_bit_cast(unsigned, w0); r[5] = __builtin_bit_cast(unsigned, w1); r[6] = __builtin_bit_cast(unsigned, rs);
        }
        ++nrec; cur[0] = nxt[0]; cur[1] = nxt[1];
    }
    __syncthreads();
    if (F.tid < 16) gbase[F.tid] = __hip_atomic_fetch_add(F.ctl + CW_MOE + 64 * F.tid, lcnt[F.tid], RLX_AGENT);
    __syncthreads();
    for (int i = F.tid; i < 17 * NWAVES; i += NTHREADS) { const int n = i / NWAVES, w = i % NWAVES; const int row = (F.vcu * NWAVES + w) + n * NGW;
        if (row < MVALID) { const LAS unsigned* r = rec + i * 8; const unsigned g0 = r[1] & 255u, g1 = r[1] >> 8; const float rs = __builtin_bit_cast(float, r[6]);
            const size_t q0 = (size_t)g0 * MP + gbase[g0] + r[2], q1 = (size_t)g1 * MP + gbase[g1] + r[3];
            list[q0] = (int)r[0]; wlist[q0] = (f32x2){__builtin_bit_cast(float, r[4]), rs}; list[q1] = (int)r[0]; wlist[q1] = (f32x2){__builtin_bit_cast(float, r[5]), rs}; } }
    __syncthreads();
}
__device__ __forceinline__ void phase_moe_init(const Frame& F) {
    const int gt = F.vcu * NTHREADS + F.tid, NGT = F.G * NTHREADS;
    int* list = (int*)(F.ws + WS_LIST);
    for (int i = gt; i < 16 * MP / 4; i += NGT) ((GAS u32x4*)list)[i] = (u32x4){0xffffffffu, 0xffffffffu, 0xffffffffu, 0xffffffffu};
    if (gt < 16) __hip_atomic_store(F.ctl + CW_MOE + 64 * gt, 0u, RLX_AGENT);
}

struct GateC { float c8, ba, bi; };
__device__ __forceinline__ unsigned gate_ab(unsigned raw, float xc, const GateC& g) {
    const float r = sigmoidf_(bflo(raw) + g.ba), ig = sigmoidf_(bfhi(raw) + g.bi);
    const float la2 = g.c8 * r, a = __builtin_amdgcn_exp2f(la2), mult = __builtin_amdgcn_sqrtf(fmaxf(1.0f - a * a, 0.f));
    return f2bf(la2) | (f2bf(mult * ig * xc) << 16);
}
__device__ __forceinline__ GateC gate_consts(const Frame& F, int l, int c) {
    const float L = ((const float*)F.in(I_LAMBDA))[l * DR + c]; const float sp = (L > 15.f) ? __expf(-L) : log1pf(__expf(-L));
    GateC g; g.c8 = -8.0f * sp * 1.4426950408889634f; g.ba = ((const float*)F.in(I_B_A))[l * DR + c]; g.bi = ((const float*)F.in(I_B_I))[l * DR + c]; return g;
}
__device__ __forceinline__ void phase_scan1(const Frame& F, int l) {
    unsigned* AB = (unsigned*)((unsigned char*)F.out + D_AB); const bf16_t* XC = (const bf16_t*)(F.ws + T_XC); f32x2* SC = (f32x2*)(F.ws + WS_SCAN); const int c = F.tid;
    const GateC gc = gate_consts(F, l, c);
    for (int u = blockIdx.x; u < NB * SCAN_NCH; u += F.G) {
        const int b = u / SCAN_NCH, k = u % SCAN_NCH; float h = 0.f, ls = 0.f;
        if (k == 0) { unsigned ma[NMETA]; bf16_t mx[NMETA];
#pragma unroll
            for (int i = 0; i < NMETA; ++i) { const size_t r = (size_t)(MR + i) * 512 + c; ma[i] = AB[r]; mx[i] = XC[r]; }
#pragma unroll
            for (int i = 0; i < NMETA; ++i) { const unsigned w = gate_ab(ma[i], bf2f(mx[i]), gc); const float la = bflo(w); h = __builtin_amdgcn_exp2f(la) * h + bfhi(w); ls += la; } }
        const size_t r0 = (size_t)(b * SEQ + k * SCAN_CH) * 512 + c;
#pragma unroll 8
        for (int i = 0; i < SCAN_CH; ++i) { const size_t r = r0 + (size_t)i * 512; const unsigned w = gate_ab(AB[r], bf2f(XC[r]), gc); AB[r] = w; const float la = bflo(w); h = __builtin_amdgcn_exp2f(la) * h + bfhi(w); ls += la; }
        SC[(size_t)u * 512 + c] = (f32x2){ls, h};
    }
}
__device__ __forceinline__ void mix_rows(const Frame& F, int row0, int nrows) {
    const bf16_t* ATT = (const bf16_t*)(F.ws + T_ATT); bf16_t* MIX = (bf16_t*)(F.ws + WS_BUFA);
    for (int i0 = F.wave; i0 < nrows; i0 += 8 * NWAVES) {
        u32x4 at[8];
#pragma unroll
        for (int m = 0; m < 8; ++m) { const int i = i0 + m * NWAVES; at[m] = (u32x4){0u, 0u, 0u, 0u}; if (i < nrows) at[m] = *(const GAS u32x4*)(ATT + (size_t)(row0 + i) * 512 + F.lane * 8); }
#pragma unroll
        for (int m = 0; m < 8; ++m) { const int i = i0 + m * NWAVES; const int row = row0 + i; if (i < nrows) {
#pragma unroll
        for (int which = 0; which < 2; ++which) {
            const u32x4 w = which ? *(const LAS u32x4*)(F.lds + (size_t)i * 1024 + F.lane * 16) : at[m];
            float x[8] = {bflo(w.x), bfhi(w.x), bflo(w.y), bfhi(w.y), bflo(w.z), bfhi(w.z), bflo(w.w), bfhi(w.w)}; float s = 0.f;
#pragma unroll
            for (int j = 0; j < 8; ++j) s += x[j] * x[j];
            const float rs = __builtin_amdgcn_rsqf(wave_sum(s, F.lane) * (1.f / 512) + EPS);
            *(GAS u32x4*)(MIX + (size_t)row * DM + which * 512 + F.lane * 8) = (u32x4){pg8::cvt_pk_bf16(x[0] * rs, x[1] * rs), pg8::cvt_pk_bf16(x[2] * rs, x[3] * rs), pg8::cvt_pk_bf16(x[4] * rs, x[5] * rs), pg8::cvt_pk_bf16(x[6] * rs, x[7] * rs)};
        } } }
    }
}
__device__ __forceinline__ void phase_scan3_mix(const Frame& F, int l) {
    const unsigned* AB = (const unsigned*)((unsigned char*)F.out + D_AB); const bf16_t* XC = (const bf16_t*)(F.ws + T_XC); const f32x2* SC = (const f32x2*)(F.ws + WS_SCAN); const bf16_t* GT = (const bf16_t*)(F.ws + T_GT); const int c = F.tid;
    LAS bf16_t* rl = (LAS bf16_t*)F.lds;
    const GateC gc = gate_consts(F, l, c);
    for (int u = blockIdx.x; u < NB * SCAN_NCH; u += F.G) {
        const int b = u / SCAN_NCH, k = u % SCAN_NCH; float h = 0.f;
        { f32x2 sc[SCAN_NCH];
#pragma unroll
          for (int kk = 0; kk < SCAN_NCH; ++kk) { sc[kk] = (f32x2){0.f, 0.f}; if (kk < k) sc[kk] = SC[(size_t)(b * SCAN_NCH + kk) * 512 + c]; }
#pragma unroll
          for (int kk = 0; kk < SCAN_NCH; ++kk) h = __builtin_amdgcn_exp2f(sc[kk].x) * h + sc[kk].y; }
        if (k == 0) { unsigned ma[NMETA]; bf16_t mx[NMETA], mg[NMETA];
#pragma unroll
            for (int i = 0; i < NMETA; ++i) { const size_t r = (size_t)(MR + i) * 512 + c; ma[i] = AB[r]; mx[i] = XC[r]; mg[i] = GT[r]; }
#pragma unroll
            for (int i = 0; i < NMETA; ++i) { const unsigned w = gate_ab(ma[i], bf2f(mx[i]), gc); h = __builtin_amdgcn_exp2f(bflo(w)) * h + bfhi(w);
                if (b == 0) rl[i * 512 + c] = (bf16_t)f2bf(h * gelu_tanhf_(bf2f(mg[i]))); }
            if (b == 0) { __syncthreads(); mix_rows(F, MR, NMETA); __syncthreads(); } }
        const size_t r0 = (size_t)(b * SEQ + k * SCAN_CH) * 512 + c;
#pragma unroll 16
        for (int i = 0; i < SCAN_CH; ++i) { const size_t r = r0 + (size_t)i * 512; const unsigned w = AB[r]; h = __builtin_amdgcn_exp2f(bflo(w)) * h + bfhi(w); rl[i * 512 + c] = (bf16_t)f2bf(h * gelu_tanhf_(bf2f(GT[r]))); }
        __syncthreads(); mix_rows(F, b * SEQ + k * SCAN_CH, SCAN_CH); __syncthreads();
    }
}

#define EPI_ROWS_BEGIN _Pragma("unroll") for (int ai = 0; ai < 2; ++ai) _Pragma("unroll") for (int m = 0; m < 4; ++m) { const int rloc = ai * 128 + wr * 64 + m * 16 + fr; const int row = u.pm * 256 + rloc; (void)row;
#define EPI_ROWS_END }
__device__ __forceinline__ u32x4 pack8(const f32x4 a, const f32x4 b) { u32x4 w; w.x = pg8::cvt_pk_bf16(a[0], a[1]); w.y = pg8::cvt_pk_bf16(a[2], a[3]); w.z = pg8::cvt_pk_bf16(b[0], b[1]); w.w = pg8::cvt_pk_bf16(b[2], b[3]); return w; }

__device__ __forceinline__ float ssq16(const float* p) { const f32x4 a = *(const GAS f32x4*)p, b = *(const GAS f32x4*)(p + 4), c = *(const GAS f32x4*)(p + 8), d = *(const GAS f32x4*)(p + 12);
    return ((a.x + a.y) + (a.z + a.w)) + ((b.x + b.y) + (b.z + b.w)) + ((c.x + c.y) + (c.z + c.w)) + ((d.x + d.y) + (d.z + d.w)); }
__device__ __forceinline__ float ssq16c(const float* p, int fq, int lane) { const f32x4 a = *(const GAS f32x4*)(p + 4 * fq); float s = (a.x + a.y) + (a.z + a.w); s += shfl_xor_(s, 16, lane); s += shfl_xor_(s, 32, lane); return s; }
__device__ __forceinline__ f32x2 swiglu2(const f32x2 g, const f32x2 u, const f32x2 sneg, const f32x2 ws2) {
    const f32x2 t = g * sneg; const f32x2 d = (f32x2){__builtin_amdgcn_exp2f(t.x), __builtin_amdgcn_exp2f(t.y)} + (f32x2){1.0f, 1.0f};
    const f32x2 r = {__builtin_amdgcn_rcpf(d.x), __builtin_amdgcn_rcpf(d.y)}; return (g * u) * (r * ws2); }
__device__ __forceinline__ f32x4 swiglu4(const f32x4 g, const f32x4 u, float sneg, float ws2) {
    const f32x2 sn = {sneg, sneg}, w2 = {ws2, ws2};
    const f32x2 lo = swiglu2(__builtin_shufflevector(g, g, 0, 1), __builtin_shufflevector(u, u, 0, 1), sn, w2), hi = swiglu2(__builtin_shufflevector(g, g, 2, 3), __builtin_shufflevector(u, u, 2, 3), sn, w2);
    return __builtin_shufflevector(lo, hi, 0, 1, 2, 3); }
__device__ __forceinline__ f32x2 swiglu2i(const f32x2 g, const f32x2 u, const f32x2 sneg, const f32x2 iw) {
    const f32x2 t = g * sneg; const f32x2 e = {__builtin_amdgcn_exp2f(t.x), __builtin_amdgcn_exp2f(t.y)}; const f32x2 d = e * iw + iw;
    const f32x2 r = {__builtin_amdgcn_rcpf(d.x), __builtin_amdgcn_rcpf(d.y)}; return (g * u) * r; }
__device__ __forceinline__ f32x4 swiglu4i(const f32x4 g, const f32x4 u, float sneg, float iw) {
    const f32x2 sn = {sneg, sneg}, w2 = {iw, iw};
    const f32x2 lo = swiglu2i(__builtin_shufflevector(g, g, 0, 1), __builtin_shufflevector(u, u, 0, 1), sn, w2), hi = swiglu2i(__builtin_shufflevector(g, g, 2, 3), __builtin_shufflevector(u, u, 2, 3), sn, w2);
    return __builtin_shufflevector(lo, hi, 0, 1, 2, 3); }
__device__ __forceinline__ float sq4(const f32x4 v) { return (v[0] * v[0] + v[1] * v[1]) + (v[2] * v[2] + v[3] * v[3]); }
struct EpiUp {
    static constexpr bool PERM = true; bf16_t* O; int ldc; const float* SSQC; int off, cnt; float invdim;
    template <class S> __device__ __forceinline__ void operator()(const f32x4 (&acc)[2][2][4][2], const pg8::Unit& u, const S&, int wr, int wc, int fr, int fq) const {
        float rsv[2][4];
        EPI_ROWS_BEGIN const float* sp = SSQC + (size_t)row * 16 + off; f32x4 t = *(const GAS f32x4*)sp; if (cnt == 8) t = t + *(const GAS f32x4*)(sp + 4);
            rsv[ai][m] = __builtin_amdgcn_rsqf(((t.x + t.y) + (t.z + t.w)) * invdim + EPS);
        EPI_ROWS_END
        EPI_ROWS_BEGIN const float rs = rsv[ai][m];
            bf16_t* rp = O + (size_t)row * ldc + u.pn * 256 + wc * 32 + 8 * fq;
#pragma unroll
            for (int bj = 0; bj < 2; ++bj) *(GAS u32x4*)(rp + bj * 128) = pack8(acc[ai][bj][m][0] * rs, acc[ai][bj][m][1] * rs);
        EPI_ROWS_END
    }
};
struct EpiKV {
    static constexpr bool PERM = true; bf16_t* Kb; bf16_t* Vb; const float* SSQC; const bf16_t* CQ; const float* rope; const float* kg;
    template <class S> __device__ __forceinline__ void operator()(const f32x4 (&acc)[2][2][4][2], const pg8::Unit& u, const S&, int wr, int wc, int fr, int fq_) const {
        int fq = fq_; asm volatile("" : "+v"(fq));
        const int lane = fr + 16 * fq;
        if (u.pn < 2) {
            const int h = 4 * u.pn + wc; float rsv[2][4], rkv[2][4];
            EPI_ROWS_BEGIN const float* sp = SSQC + (size_t)row * 16; const f32x4 t = *(const GAS f32x4*)(sp + 8); const float rs = __builtin_amdgcn_rsqf(((t.x + t.y) + (t.z + t.w)) * (1.f / KVL) + EPS), skr = sp[12];
                float ss = 0.f;
#pragma unroll
                for (int bj = 0; bj < 2; ++bj)
#pragma unroll
                    for (int n = 0; n < 2; ++n) ss += sq4(acc[ai][bj][m][n]);
                ss += shfl_xor_(ss, 16, lane); ss += shfl_xor_(ss, 32, lane);
                const float rk = __builtin_amdgcn_rsqf((ss * rs * rs + skr) * (1.f / QKH) + EPS); rsv[ai][m] = rs * rk; rkv[ai][m] = rk;
            EPI_ROWS_END
#pragma unroll
            for (int bj = 0; bj < 2; ++bj) { const f32x4 g0 = *(const GAS f32x4*)(kg + 32 * bj + 8 * fq), g1 = *(const GAS f32x4*)(kg + 32 * bj + 8 * fq + 4);
                EPI_ROWS_BEGIN *(GAS u32x4*)((unsigned char*)Kb + ((size_t)(row >> 6) * 8 + h) * 12288 + (4 * bj + fq) * 1024 + (row & 63) * 16) = pack8(acc[ai][bj][m][0] * g0 * rsv[ai][m], acc[ai][bj][m][1] * g1 * rsv[ai][m]); EPI_ROWS_END }
            { const f32x4 gr1 = *(const GAS f32x4*)(kg + 64 + 4 * fq), gr2 = *(const GAS f32x4*)(kg + 80 + 4 * fq);
              u32x2 k1v[2][4], k2v[2][4]; f32x4 ccv[2][4], snv[2][4];
              EPI_ROWS_BEGIN k1v[ai][m] = *(const GAS u32x2*)(CQ + (size_t)row * 512 + 384 + 4 * fq); k2v[ai][m] = *(const GAS u32x2*)(CQ + (size_t)row * 512 + 400 + 4 * fq);
                ccv[ai][m] = *(const GAS f32x4*)(rope + (size_t)row * 32 + 4 * fq); snv[ai][m] = *(const GAS f32x4*)(rope + (size_t)row * 32 + 16 + 4 * fq); EPI_ROWS_END
              EPI_ROWS_BEGIN const float rk = rkv[ai][m]; unsigned char* kp = (unsigned char*)Kb + ((size_t)(row >> 6) * 8 + h) * 12288 + (row & 63) * 16 + (8 + (fq >> 1)) * 1024 + (fq & 1) * 8;
                const u32x2 k1 = k1v[ai][m], k2 = k2v[ai][m]; const f32x4 cc = ccv[ai][m], sn = snv[ai][m];
                const f32x4 y1 = (f32x4){bflo(k1.x), bfhi(k1.x), bflo(k1.y), bfhi(k1.y)} * gr1 * rk, y2 = (f32x4){bflo(k2.x), bfhi(k2.x), bflo(k2.y), bfhi(k2.y)} * gr2 * rk;
                const f32x4 o1 = y1 * cc - y2 * sn, o2 = y2 * cc + y1 * sn;
                *(GAS u32x2*)kp = (u32x2){pg8::cvt_pk_bf16(o1[0], o1[1]), pg8::cvt_pk_bf16(o1[2], o1[3])}; *(GAS u32x2*)(kp + 2048) = (u32x2){pg8::cvt_pk_bf16(o2[0], o2[1]), pg8::cvt_pk_bf16(o2[2], o2[3])};
              EPI_ROWS_END }
        } else {
            float rsv[2][4];
            EPI_ROWS_BEGIN const f32x4 t = *(const GAS f32x4*)(SSQC + (size_t)row * 16 + 8); rsv[ai][m] = __builtin_amdgcn_rsqf(((t.x + t.y) + (t.z + t.w)) * (1.f / KVL) + EPS); EPI_ROWS_END
            EPI_ROWS_BEGIN const float rs = rsv[ai][m];
                unsigned char* vp = (unsigned char*)Vb + ((size_t)(row >> 6) * 8 + 4 * (u.pn - 2) + (wc >> 1)) * 8192 + ((wc & 1) * 4 + ((row & 63) >> 4)) * 1024 + ((row & 15) * 4 + fq) * 16;
#pragma unroll
                for (int bj = 0; bj < 2; ++bj) *(GAS u32x4*)(vp + bj * 2 * 8192) = pack8(acc[ai][bj][m][0] * rs, acc[ai][bj][m][1] * rs);
            EPI_ROWS_END
        }
    }
};
struct EpiProj {
    static constexpr bool PERM = true; unsigned char* ws; const float* SSQ1; float* SSQC;
    template <class S> __device__ __forceinline__ void operator()(const f32x4 (&acc)[2][2][4][2], const pg8::Unit& u, const S&, int wr, int wc, int fr, int fq) const {
        bf16_t* base; int ld, c0; const int lane = fr + 16 * fq;
        if (u.pn < 2) { base = (bf16_t*)(ws + T_CQ); ld = 512; c0 = 256 * u.pn; } else if (u.pn == 2) { base = (bf16_t*)(ws + T_CKV); ld = 256; c0 = 0; }
        else if (u.pn < 5) { base = (bf16_t*)(ws + T_XR); ld = 512; c0 = 256 * (u.pn - 3); } else { base = (bf16_t*)(ws + T_GT); ld = 512; c0 = 256 * (u.pn - 5); }
        float rsv[2][4];
        EPI_ROWS_BEGIN rsv[ai][m] = __builtin_amdgcn_rsqf(ssq16c(SSQ1 + (size_t)row * 16, fq, lane) * (1.f / DM) + EPS); EPI_ROWS_END
        EPI_ROWS_BEGIN const float rs = rsv[ai][m];
            bf16_t* rp = base + (size_t)row * ld + c0 + wc * 32 + 8 * fq; float ss = 0.f;
#pragma unroll
            for (int bj = 0; bj < 2; ++bj) { const f32x4 v0 = acc[ai][bj][m][0] * rs, v1 = acc[ai][bj][m][1] * rs; __builtin_nontemporal_store(pack8(v0, v1), (GAS u32x4*)(rp + bj * 128));
                if (u.pn != 1 || bj == 0) ss += sq4(v0) + sq4(v1); }
            if (u.pn < 3) { ss += shfl_xor_(ss, 16, lane); ss += shfl_xor_(ss, 32, lane); if (fq == 0) SSQC[(size_t)row * 16 + (u.pn == 0 ? 0 : (u.pn == 1 ? 4 : 8)) + wc] = ss; }
            if (u.pn == 1 && wc == 0) { float sk = sq4(acc[ai][1][m][0] * rs) + sq4(acc[ai][1][m][1] * rs); sk += shfl_xor_(sk, 16, lane); sk += shfl_xor_(sk, 32, lane); if (fq == 0) SSQC[(size_t)row * 16 + 12] = sk; }
        EPI_ROWS_END
    }
};
struct EpiGates {
    static constexpr bool PERM = true; unsigned* AB;
    template <class S> __device__ __forceinline__ void operator()(const f32x4 (&acc)[2][2][4][2], const pg8::Unit& u, const S&, int wr, int wc, int fr, int fq) const {
        const int ch0 = 128 * u.pn + wc * 32 + 8 * fq;
        EPI_ROWS_BEGIN GAS u32x4* op = (GAS u32x4*)(AB + (size_t)row * 512 + ch0);
#pragma unroll
            for (int n = 0; n < 2; ++n) { u32x4 o;
#pragma unroll
                for (int i = 0; i < 4; ++i) o[i] = pg8::cvt_pk_bf16(acc[ai][0][m][n][i], acc[ai][1][m][n][i]);
                op[n] = o; }
        EPI_ROWS_END
    }
};
struct EpiRes {
    static constexpr bool PERM = true; bf16_t* HB; float* SSQ; unsigned char* HB8; float ascale;
    template <class S> __device__ __forceinline__ void operator()(const f32x4 (&acc)[2][2][4][2], const pg8::Unit& u, const S&, int wr, int wc, int fr, int fq) const {
        const int col = u.pn * 256 + wc * 32 + 8 * fq, lane = fr + 16 * fq;
        u32x4 rw[2][4][2];
        EPI_ROWS_BEGIN const bf16_t* hp = HB + (size_t)row * DM + col; rw[ai][m][0] = *(const GAS u32x4*)hp; rw[ai][m][1] = *(const GAS u32x4*)(hp + 128); EPI_ROWS_END
        EPI_ROWS_BEGIN bf16_t* hp = HB + (size_t)row * DM + col; float ss = 0.f;
#pragma unroll
            for (int bj = 0; bj < 2; ++bj) { const u32x4 w = rw[ai][m][bj];
                const f32x4 v0 = (f32x4){bflo(w.x), bfhi(w.x), bflo(w.y), bfhi(w.y)} + acc[ai][bj][m][0] * ascale, v1 = (f32x4){bflo(w.z), bfhi(w.z), bflo(w.w), bfhi(w.w)} + acc[ai][bj][m][1] * ascale;
                *(GAS u32x4*)(hp + bj * 128) = pack8(v0, v1); ss += sq4(v0) + sq4(v1);
                if (HB8) *(GAS u32x2*)(HB8 + (size_t)row * DM + col + bj * 128) = (u32x2){pk4_fp8(v0[0], v0[1], v0[2], v0[3]), pk4_fp8(v1[0], v1[1], v1[2], v1[3])}; }
            ss += shfl_xor_(ss, 16, lane); ss += shfl_xor_(ss, 32, lane); if (fq == 0) SSQ[(size_t)row * 16 + u.pn * 4 + wc] = ss;
        EPI_ROWS_END
    }
};
struct EpiSwiGLU {
    static constexpr bool PERM = true; bf16_t* ACT; int ldc; const float* SSQ; float oscale; unsigned char* ACT8;
    static constexpr bool CACHE_ROWS = true;
    template <class S> __device__ __forceinline__ void operator()(const f32x4 (&acc)[2][2][4][2], const pg8::Unit& u, const S&, int wr, int wc, int fr_, int fq_, float (&rc)[16], int& rc_pm) const {
        int fr = fr_, fq = fq_; asm volatile("" : "+v"(fr), "+v"(fq));
        const int lane = fr + 16 * fq;
        if (u.pm != rc_pm) { rc_pm = u.pm;
            EPI_ROWS_BEGIN const float rs = __builtin_amdgcn_rsqf(ssq16c(SSQ + (size_t)row * 16, fq, lane) * (1.f / DM) + EPS) * oscale; rc[2 * (ai * 4 + m)] = -1.4426950408889634f * rs; rc[2 * (ai * 4 + m) + 1] = __builtin_amdgcn_rcpf(rs * rs); EPI_ROWS_END }
        const unsigned off0 = __umul24((unsigned)(u.pm * 256 + wr * 64 + fr), (unsigned)ldc) + (unsigned)(u.pn * 128 + wc * 32 + 8 * fq);
        EPI_ROWS_BEGIN f32x4 v0, v1;
#pragma unroll
            for (int i = 0; i < 1; ++i) { const float sneg = rc[2 * (ai * 4 + m)], iw = rc[2 * (ai * 4 + m) + 1]; v0 = swiglu4i(acc[ai][0][m][0], acc[ai][1][m][0], sneg, iw); v1 = swiglu4i(acc[ai][0][m][1], acc[ai][1][m][1], sneg, iw); }
            const unsigned off = off0 + (unsigned)((ai * 128 + m * 16) * ldc);
            if (ACT8) *(GAS u32x2*)(ACT8 + off) = (u32x2){pk4_fp8(v0[0], v0[1], v0[2], v0[3]), pk4_fp8(v1[0], v1[1], v1[2], v1[3])};
            else *(GAS u32x4*)(ACT + off) = pack8(v0, v1);
        EPI_ROWS_END
    }
};
struct MoeOrder {               static constexpr bool THIN_META = false;
    int nN, G, c, p0, p1; const LAS int* pfx; const int* list; const f32x2* wlist; unsigned estride;
    __device__ bool next(int i, pg8::Unit& u) const {
        const int nM = p1 - p0, nwg = nM * nN; const long L = (long)i * G + c; if (L >= nwg) return false;
        int wgid = (int)L; { const int q = nwg / pg8::NXCD, r = nwg % pg8::NXCD, xcd = wgid % pg8::NXCD, off = wgid / pg8::NXCD; wgid = (xcd < r ? xcd * (q + 1) : r * (q + 1) + (xcd - r) * q) + off; }
        const int nig = pg8::WGM * nN, gid = wgid / nig, fm = gid * pg8::WGM, gsz = (nM - fm) < pg8::WGM ? (nM - fm) : pg8::WGM;
        const int P = p0 + fm + ((wgid % nig) % gsz), pnn = (wgid % nig) / gsz; int g = 0;
#pragma unroll
        for (int q = 1; q < 16; ++q) g += (pfx[q] <= P) ? 1 : 0;
        g = __builtin_amdgcn_readfirstlane(g);
        u.pm = P; u.pn = pnn; u.grp = g; u.prow = __builtin_amdgcn_readfirstlane((P - pfx[g]) * 256); u.aoff = 0; u.boff = (unsigned)(g & 7) * estride; return true;
    }
    __device__ __forceinline__ int arow(const pg8::Unit& u, int r) const { const int idx = list[(size_t)u.grp * MP + u.prow + r]; return idx < 0 ? MP - 1 : idx; }
};
struct EpiSwiGLUMoe {
    static constexpr bool PERM = true; bf16_t* ACT;
    static constexpr bool CACHE_ROWS = true;
    __device__ __forceinline__ void operator()(const f32x4 (&acc)[2][2][4][2], const pg8::Unit& u, const MoeOrder& S, int wr, int wc, int fr, int fq, float (&rc)[16], int& rc_pm) const {
        const unsigned off0 = __umul24((unsigned)(u.pm * 256 + wr * 64 + fr), (unsigned)DFE8) + (unsigned)(u.pn * 128 + wc * 32 + 8 * fq);
        if (u.pm != rc_pm) { rc_pm = u.pm;
            EPI_ROWS_BEGIN const size_t li = (size_t)u.grp * MP + u.prow + rloc; f32x2 wr2 = S.wlist[li]; if (S.list[li] < 0) wr2 = (f32x2){0.f, 0.f}; rc[2 * (ai * 4 + m)] = wr2.x; rc[2 * (ai * 4 + m) + 1] = wr2.y * (1.f / 64.f); EPI_ROWS_END }
        EPI_ROWS_BEGIN const float w = rc[2 * (ai * 4 + m)], rs = rc[2 * (ai * 4 + m) + 1]; f32x4 v0, v1;
#pragma unroll
            for (int i = 0; i < 1; ++i) { const float sneg = -1.4426950408889634f * rs, ws2 = w * rs * rs; v0 = swiglu4(acc[ai][0][m][0], acc[ai][1][m][0], sneg, ws2); v1 = swiglu4(acc[ai][0][m][1], acc[ai][1][m][1], sneg, ws2); }
            unsigned char* ap = (unsigned char*)ACT + (off0 + (unsigned)((ai * 128 + m * 16) * DFE8));
            *(GAS u32x2*)ap = (u32x2){pk4_fp8(v0[0], v0[1], v0[2], v0[3]), pk4_fp8(v1[0], v1[1], v1[2], v1[3])};
            if (u.pn == 2 * DFE / 256 - 1) *(GAS u32x2*)(ap + 128) = (u32x2){0u, 0u};
        EPI_ROWS_END
    }
};
struct EpiMoeDown {
    static constexpr bool PERM = true; bf16_t* HB; float* SSQ; float* out; int mode;
    __device__ __forceinline__ void operator()(const f32x4 (&acc)[2][2][4][2], const pg8::Unit& u, const MoeOrder& S, int wr, int wc, int fr, int fq) const {
        const int col = u.pn * 256 + wc * 32 + 8 * fq, lane = fr + 16 * fq;
        int tokv[2][4]; u32x4 rw[2][4][2];
        EPI_ROWS_BEGIN tokv[ai][m] = S.list[(size_t)u.grp * MP + u.prow + rloc]; EPI_ROWS_END
        EPI_ROWS_BEGIN const int tok = tokv[ai][m]; const int tr = tok >= 0 ? tok : MP - 1; const bf16_t* hp = HB + (size_t)tr * DM + col; rw[ai][m][0] = *(const GAS u32x4*)hp; rw[ai][m][1] = *(const GAS u32x4*)(hp + 128); EPI_ROWS_END
        EPI_ROWS_BEGIN const int tok = tokv[ai][m]; const bool ok = tok >= 0; const int tr = ok ? tok : MP - 1;
            bf16_t* hp = HB + (size_t)tr * DM + col; float ss = 0.f;
#pragma unroll
            for (int bj = 0; bj < 2; ++bj) { const u32x4 w = rw[ai][m][bj];
                const f32x4 v0 = (f32x4){bflo(w.x), bfhi(w.x), bflo(w.y), bfhi(w.y)} + acc[ai][bj][m][0] * (1.f / 64.f), v1 = (f32x4){bflo(w.z), bfhi(w.z), bflo(w.w), bfhi(w.w)} + acc[ai][bj][m][1] * (1.f / 64.f);
                ss += sq4(v0) + sq4(v1);
                if (mode == 2) { if (ok && tok < MR) { float* op = out + (size_t)tok * DM + col + bj * 128; *(GAS f32x4*)op = v0; *(GAS f32x4*)(op + 4) = v1; } }
                else if (ok) *(GAS u32x4*)(hp + bj * 128) = pack8(v0, v1); }
            if (mode == 1) { ss += shfl_xor_(ss, 16, lane); ss += shfl_xor_(ss, 32, lane); if (fq == 0 && ok) SSQ[(size_t)tok * 16 + u.pn * 4 + wc] = ss; }
        EPI_ROWS_END
    }
};
__device__ __forceinline__ void moe_prefix(const Frame& F) {
    LAS int* pfx = (LAS int*)(F.lds + LDSCTL_OFF); LAS int* npan = pfx + 32;
    __syncthreads();
    if (F.tid < 16) { const unsigned c = __hip_atomic_load(F.ctl + CW_MOE + 64 * F.tid, RLX_AGENT); npan[F.tid] = (int)((c + 255u) >> 8); }
    __syncthreads();
    if (F.tid == 0) { int s = 0;
        for (int g = 0; g < 16; ++g) { pfx[g] = s; s += npan[g]; } pfx[16] = s; }
    __syncthreads();
}

namespace att {
typedef float f32x16 __attribute__((ext_vector_type(16)));
typedef short s16x4 __attribute__((ext_vector_type(4)));
constexpr int KSLOT = 12288, VSLOT = 8192, NSLOT = 3;
constexpr int L_K = 0, L_V = NSLOT * KSLOT, L_WS = L_V + NSLOT * VSLOT, L_OST = L_WS + NWAVES * 256, L_END = L_OST + NWAVES * 4096;
static_assert(L_END <= RING_BYTES, "attention LDS");
__device__ __forceinline__ int crow(int r, int hi) { return (r & 3) + 8 * (r >> 2) + 4 * hi; }
__device__ __forceinline__ float xhalf(float v, int lane) { return shfl_xor_(v, 32, lane); }
__device__ __forceinline__ unsigned cvtpk(float lo, float hi) { typedef float f2 __attribute__((ext_vector_type(2))); typedef __bf16 b2 __attribute__((ext_vector_type(2))); f2 v = {lo, hi}; b2 b = __builtin_convertvector(v, b2); return __builtin_bit_cast(unsigned, b); }
__device__ __forceinline__ float max3f(float a, float b, float c) { float r; asm("v_max3_f32 %0, %1, %2, %3" : "=v"(r) : "v"(a), "v"(b), "v"(c)); return r; }
#define ATT_SB() __builtin_amdgcn_sched_barrier(0)

__device__ __forceinline__ void attn_unit(const Frame& F, int bb, int h, int qb, const float* qg, const float sh) {
    const bf16_t* Q = (const bf16_t*)((unsigned char*)F.out + D_Q); const bf16_t* Kb = (const bf16_t*)(F.ws + T_K); const bf16_t* Vb = (const bf16_t*)(F.ws + T_V); bf16_t* ATT = (bf16_t*)(F.ws + T_ATT);
    const int lane = F.lane, wid = F.wave, r32 = lane & 31, hi = lane >> 5;
    const bool meta = bb < 0;
    const int qrow0 = meta ? MR : bb * SEQ + qb * 256;
    const int krow_b = meta ? 0 : bb * SEQ;
    const int NT = meta ? 1 : 1 + 4 * (qb + 1);
    const int NTw = meta ? 1 : 4 * qb + 2 + (wid >> 1);
    LAS unsigned char* lds = F.lds;
    LAS float* wsf = (LAS float*)(lds + L_WS) + wid * 64;
    const unsigned kvoff = (unsigned)lane * 16u;
    const unsigned vvoff = kvoff;
#define ATT_KROW(t) ((t) == 0 ? MR : krow_b + 64 * ((t) - 1))
#define ATT_DMA_K(t, slot) do { const char* kb_ = pg8::uptr((const char*)Kb + ((size_t)(ATT_KROW(t) >> 6) * 8 + h) * 12288 + wid * 1024); const unsigned ld_ = (unsigned)__builtin_amdgcn_readfirstlane((int)(lds0 + L_K + (slot) * KSLOT + wid * 1024)); \
        glds16(kb_, kvoff, ld_); if (wid < 4) glds16(kb_ + 8192, kvoff, ld_ + 8192u); } while (0)
#define ATT_DMA_V(t, slot) do { const char* vb_ = pg8::uptr((const char*)Vb + ((size_t)(ATT_KROW(t) >> 6) * 8 + h) * 8192 + wid * 1024); \
        glds16(vb_, vvoff, (unsigned)__builtin_amdgcn_readfirstlane((int)(lds0 + L_V + (slot) * VSLOT + wid * 1024))); } while (0)
    const unsigned lds0 = (unsigned)(uintptr_t)lds;
    ATT_DMA_K(0, 0); if (NT > 1) ATT_DMA_K(1, 1); ATT_DMA_V(0, 0);
    bf16x8 qf[6];
    { const int qrow = qrow0 + wid * 32 + r32; const bf16_t* qp = Q + (size_t)qrow * 768 + h * 96 + 8 * hi; float x[6][8]; float ss = 0.f;
#pragma unroll
      for (int c = 0; c < 6; ++c) { const u32x4 w = *(const GAS u32x4*)(qp + 16 * c); x[c][0] = bflo(w.x); x[c][1] = bfhi(w.x); x[c][2] = bflo(w.y); x[c][3] = bfhi(w.y); x[c][4] = bflo(w.z); x[c][5] = bfhi(w.z); x[c][6] = bflo(w.w); x[c][7] = bfhi(w.w);
#pragma unroll
          for (int j = 0; j < 8; ++j) ss += x[c][j] * x[c][j]; }
      ss += xhalf(ss, lane);
      const float rq = __builtin_amdgcn_rsqf(ss * (1.f / QKH) + EPS) * (0.10206207261596575f * 1.4426950408889634f);
#pragma unroll
      for (int c = 0; c < 6; ++c) { const f32x4 g0 = *(const GAS f32x4*)(qg + 16 * c + 8 * hi), g1 = *(const GAS f32x4*)(qg + 16 * c + 8 * hi + 4);
#pragma unroll
          for (int j = 0; j < 4; ++j) { x[c][j] *= rq * g0[j]; x[c][4 + j] *= rq * g1[j]; } }
      const float* rp = (const float*)(F.ws + WS_ROPE) + (size_t)qrow * 32 + 8 * hi;
      const f32x4 c0 = *(const GAS f32x4*)rp, c1 = *(const GAS f32x4*)(rp + 4), s0 = *(const GAS f32x4*)(rp + 16), s1 = *(const GAS f32x4*)(rp + 20);
#pragma unroll
      for (int j = 0; j < 8; ++j) { const float cc = j < 4 ? c0[j & 3] : c1[j & 3], sn = j < 4 ? s0[j & 3] : s1[j & 3]; const float y1 = x[4][j], y2 = x[5][j]; x[4][j] = y1 * cc - y2 * sn; x[5][j] = y2 * cc + y1 * sn; }
#pragma unroll
      for (int c = 0; c < 6; ++c) { const u32x4 w = {cvtpk(x[c][0], x[c][1]), cvtpk(x[c][2], x[c][3]), cvtpk(x[c][4], x[c][5]), cvtpk(x[c][6], x[c][7])}; qf[c] = __builtin_bit_cast(bf16x8, w); } }
    asm volatile("s_waitcnt vmcnt(0)" ::: "memory");
    f32x16 o0 = {}, o1 = {}; float l_run = 0.f;
    const int qpos = meta ? r32 : qb * 256 + wid * 32 + r32;
    const LAS unsigned char* kfb = lds + L_K + hi * 1024 + r32 * 16;
    const LAS unsigned char* vfb = lds + L_V + ((lane >> 4) & 1) * 32 + (lane & 3) * 8 + (4 * hi + ((lane & 15) >> 2)) * 64;
    f32x16 A0, A1, B0, B1;
    u32x4 w0, w1, w2, w3;
#define ATT_VF(ks, d0) ({ const s16x4 lo_ = __builtin_bit_cast(s16x4, __builtin_amdgcn_ds_read_tr16_b64_v4i16((LAS s16x4*)(vp + (d0) * 4096 + (ks) * 1024))); \
        const s16x4 hh_ = __builtin_bit_cast(s16x4, __builtin_amdgcn_ds_read_tr16_b64_v4i16((LAS s16x4*)(vp + (d0) * 4096 + (ks) * 1024 + 512))); \
        (bf16x8){lo_[0], lo_[1], lo_[2], lo_[3], hh_[0], hh_[1], hh_[2], hh_[3]}; })
#define ATT_PACK4(W, P, B) do { W = (u32x4){cvtpk(P[B], P[B + 1]), cvtpk(P[B + 2], P[B + 3]), cvtpk(P[B + 4], P[B + 5]), cvtpk(P[B + 6], P[B + 7])}; \
        sacc += ((P[B] + P[B + 1]) + (P[B + 2] + P[B + 3])) + ((P[B + 4] + P[B + 5]) + (P[B + 6] + P[B + 7])); asm volatile("" : "+v"(W), "+v"(sacc)); } while (0)
#define ATT_EXP4(P, B) do { P[B] = __builtin_amdgcn_exp2f(P[B]); P[B + 1] = __builtin_amdgcn_exp2f(P[B + 1]); P[B + 2] = __builtin_amdgcn_exp2f(P[B + 2]); P[B + 3] = __builtin_amdgcn_exp2f(P[B + 3]); asm volatile("" : "+v"(P)); } while (0)
#define ATT_STEP(C0, C1, P0, P1, t, FIRST) do { \
        const LAS unsigned char* kp = kfb + kslot * KSLOT; const LAS unsigned char* vp = vfb + vslot * VSLOT; float sacc = 0.f; \
        bf16x8 ka0 = *(const LAS bf16x8*)(kp), ka1 = *(const LAS bf16x8*)(kp + 512), kb0, kb1; \
        kb0 = *(const LAS bf16x8*)(kp + 2048); kb1 = *(const LAS bf16x8*)(kp + 2048 + 512); \
        C0 = __builtin_amdgcn_mfma_f32_32x32x16_bf16(ka0, qf[0], (f32x16){}, 0, 0, 0); C1 = __builtin_amdgcn_mfma_f32_32x32x16_bf16(ka1, qf[0], (f32x16){}, 0, 0, 0); \
        ka0 = *(const LAS bf16x8*)(kp + 4096); ka1 = *(const LAS bf16x8*)(kp + 4096 + 512); if (!(FIRST)) ATT_PACK4(w0, P0, 0); ATT_SB(); \
        C0 = __builtin_amdgcn_mfma_f32_32x32x16_bf16(kb0, qf[1], C0, 0, 0, 0); C1 = __builtin_amdgcn_mfma_f32_32x32x16_bf16(kb1, qf[1], C1, 0, 0, 0); \
        kb0 = *(const LAS bf16x8*)(kp + 6144); kb1 = *(const LAS bf16x8*)(kp + 6144 + 512); if (!(FIRST)) ATT_PACK4(w1, P0, 8); ATT_SB(); \
        C0 = __builtin_amdgcn_mfma_f32_32x32x16_bf16(ka0, qf[2], C0, 0, 0, 0); C1 = __builtin_amdgcn_mfma_f32_32x32x16_bf16(ka1, qf[2], C1, 0, 0, 0); \
        ka0 = *(const LAS bf16x8*)(kp + 8192); ka1 = *(const LAS bf16x8*)(kp + 8192 + 512); if (!(FIRST)) ATT_PACK4(w2, P1, 0); ATT_SB(); \
        C0 = __builtin_amdgcn_mfma_f32_32x32x16_bf16(kb0, qf[3], C0, 0, 0, 0); C1 = __builtin_amdgcn_mfma_f32_32x32x16_bf16(kb1, qf[3], C1, 0, 0, 0); \
        kb0 = *(const LAS bf16x8*)(kp + 10240); kb1 = *(const LAS bf16x8*)(kp + 10240 + 512); if (!(FIRST)) ATT_PACK4(w3, P1, 8); ATT_SB(); \
        C0 = __builtin_amdgcn_mfma_f32_32x32x16_bf16(ka0, qf[4], C0, 0, 0, 0); C1 = __builtin_amdgcn_mfma_f32_32x32x16_bf16(ka1, qf[4], C1, 0, 0, 0); \
        bf16x8 vf0, vf1; if (!(FIRST)) { vf0 = ATT_VF(0, 0); vf1 = ATT_VF(0, 1); } ATT_SB(); \
        C0 = __builtin_amdgcn_mfma_f32_32x32x16_bf16(kb0, qf[5], C0, 0, 0, 0); C1 = __builtin_amdgcn_mfma_f32_32x32x16_bf16(kb1, qf[5], C1, 0, 0, 0); \
        l_run += sacc; \
        { const int kb_ = (t) == 0 ? 0 : 64 * ((t) - 1); \
          if ((t) == 0 || (kb_ + 63 > qb * 256 + wid * 32)) { const int lim = ((t) == 0 ? (meta ? (r32 < NMETA ? r32 : NMETA - 1) : NMETA - 1) : qpos) - kb_; \
            _Pragma("unroll") for (int r = 0; r < 16; ++r) { const int kk = crow(r, hi); if (kk > lim) C0[r] = -INFINITY; if (kk + 32 > lim) C1[r] = -INFINITY; } } } \
        if (sh != 0.f) { _Pragma("unroll") for (int r = 0; r < 16; ++r) { C0[r] -= sh; C1[r] -= sh; } } \
        ATT_SB(); \
        if (!(FIRST)) { \
            o0 = __builtin_amdgcn_mfma_f32_32x32x16_bf16(__builtin_bit_cast(bf16x8, w0), vf0, o0, 0, 0, 0); vf0 = ATT_VF(1, 0); ATT_EXP4(C0, 0); ATT_SB(); \
            o1 = __builtin_amdgcn_mfma_f32_32x32x16_bf16(__builtin_bit_cast(bf16x8, w0), vf1, o1, 0, 0, 0); vf1 = ATT_VF(1, 1); ATT_EXP4(C0, 4); ATT_SB(); \
            o0 = __builtin_amdgcn_mfma_f32_32x32x16_bf16(__builtin_bit_cast(bf16x8, w1), vf0, o0, 0, 0, 0); vf0 = ATT_VF(2, 0); ATT_EXP4(C0, 8); ATT_SB(); \
            o1 = __builtin_amdgcn_mfma_f32_32x32x16_bf16(__builtin_bit_cast(bf16x8, w1), vf1, o1, 0, 0, 0); vf1 = ATT_VF(2, 1); ATT_EXP4(C0, 12); ATT_SB(); \
            o0 = __builtin_amdgcn_mfma_f32_32x32x16_bf16(__builtin_bit_cast(bf16x8, w2), vf0, o0, 0, 0, 0); vf0 = ATT_VF(3, 0); ATT_EXP4(C1, 0); ATT_SB(); \
            o1 = __builtin_amdgcn_mfma_f32_32x32x16_bf16(__builtin_bit_cast(bf16x8, w2), vf1, o1, 0, 0, 0); vf1 = ATT_VF(3, 1); ATT_EXP4(C1, 4); ATT_SB(); \
            o0 = __builtin_amdgcn_mfma_f32_32x32x16_bf16(__builtin_bit_cast(bf16x8, w3), vf0, o0, 0, 0, 0); ATT_EXP4(C1, 8); ATT_SB(); \
            o1 = __builtin_amdgcn_mfma_f32_32x32x16_bf16(__builtin_bit_cast(bf16x8, w3), vf1, o1, 0, 0, 0); ATT_EXP4(C1, 12); ATT_SB(); \
        } else { ATT_EXP4(C0, 0); ATT_EXP4(C0, 4); ATT_EXP4(C0, 8); ATT_EXP4(C0, 12); ATT_EXP4(C1, 0); ATT_EXP4(C1, 4); ATT_EXP4(C1, 8); ATT_EXP4(C1, 12); } \
    } while (0)
#define ATT_DRAIN(P0, P1) do { const LAS unsigned char* vp = vfb + vslot * VSLOT; float sacc = 0.f; \
        ATT_PACK4(w0, P0, 0); ATT_PACK4(w1, P0, 8); ATT_PACK4(w2, P1, 0); ATT_PACK4(w3, P1, 8); l_run += sacc; \
        o0 = __builtin_amdgcn_mfma_f32_32x32x16_bf16(__builtin_bit_cast(bf16x8, w0), ATT_VF(0, 0), o0, 0, 0, 0); o1 = __builtin_amdgcn_mfma_f32_32x32x16_bf16(__builtin_bit_cast(bf16x8, w0), ATT_VF(0, 1), o1, 0, 0, 0); \
        o0 = __builtin_amdgcn_mfma_f32_32x32x16_bf16(__builtin_bit_cast(bf16x8, w1), ATT_VF(1, 0), o0, 0, 0, 0); o1 = __builtin_amdgcn_mfma_f32_32x32x16_bf16(__builtin_bit_cast(bf16x8, w1), ATT_VF(1, 1), o1, 0, 0, 0); \
        o0 = __builtin_amdgcn_mfma_f32_32x32x16_bf16(__builtin_bit_cast(bf16x8, w2), ATT_VF(2, 0), o0, 0, 0, 0); o1 = __builtin_amdgcn_mfma_f32_32x32x16_bf16(__builtin_bit_cast(bf16x8, w2), ATT_VF(2, 1), o1, 0, 0, 0); \
        o0 = __builtin_amdgcn_mfma_f32_32x32x16_bf16(__builtin_bit_cast(bf16x8, w3), ATT_VF(3, 0), o0, 0, 0, 0); o1 = __builtin_amdgcn_mfma_f32_32x32x16_bf16(__builtin_bit_cast(bf16x8, w3), ATT_VF(3, 1), o1, 0, 0, 0); \
    } while (0)
#define ATT_ITER(C0, C1, P0, P1, t, FIRST) do { \
        if ((t) + 1 < NT) { if (wid < 4) asm volatile("s_waitcnt vmcnt(3)" ::: "memory"); else asm volatile("s_waitcnt vmcnt(2)" ::: "memory"); } else asm volatile("s_waitcnt vmcnt(0)" ::: "memory"); \
        __builtin_amdgcn_s_barrier(); asm volatile("" ::: "memory"); \
        if ((t) + 2 < NT) ATT_DMA_K((t) + 2, kslot == 0 ? 2 : kslot - 1); \
        if ((t) + 1 < NT) ATT_DMA_V((t) + 1, kslot == 2 ? 0 : kslot + 1); \
        if (FIRST) { ATT_STEP(C0, C1, P0, P1, t, true); } else { if ((t) < NTw) ATT_STEP(C0, C1, P0, P1, t, false); else if ((t) == NTw) ATT_DRAIN(P0, P1); } \
        vslot = kslot; kslot = kslot == 2 ? 0 : kslot + 1; \
    } while (0)
    int kslot = 0, vslot = 2;
    ATT_ITER(A0, A1, B0, B1, 0, true);
    for (int t = 1; t <= NT; t += 2) {
        ATT_ITER(B0, B1, A0, A1, t, false);
        if (t + 1 > NT) break;
        ATT_ITER(A0, A1, B0, B1, t + 1, false);
    }
    const float lt = l_run + xhalf(l_run, lane);
    if (hi == 0) wsf[32 + r32] = 1.0f / lt;
    asm volatile("s_waitcnt lgkmcnt(0)" ::: "memory");
    LAS bf16_t* stg = (LAS bf16_t*)(lds + L_OST) + wid * 2048;
#pragma unroll
    for (int g = 0; g < 4; ++g) { const f32x4 ff = *(const LAS f32x4*)(wsf + 32 + 8 * g + 4 * hi);
#pragma unroll
        for (int e = 0; e < 4; ++e) { const int q = 8 * g + 4 * hi + e; const bool ok = !meta || (wid == 0 && q < NMETA);
            stg[q * 64 + r32] = (bf16_t)f2bf(ok ? o0[4 * g + e] * ff[e] : 0.f); stg[q * 64 + 32 + r32] = (bf16_t)f2bf(ok ? o1[4 * g + e] * ff[e] : 0.f); } }
    asm volatile("s_waitcnt lgkmcnt(0)" ::: "memory");
    bf16_t* op = ATT + (size_t)(qrow0 + wid * 32) * 512 + h * 64;
#pragma unroll
    for (int i = 0; i < 4; ++i) { int ln = lane; asm volatile("" : "+v"(ln));
        const int row = i * 8 + (ln >> 3), ch = ln & 7; const u32x4 v = *(const LAS u32x4*)(stg + row * 64 + ch * 8); *(GAS u32x4*)(op + (size_t)row * 512 + ch * 8) = v; }
    asm volatile("s_waitcnt vmcnt(0) lgkmcnt(0)" ::: "memory"); __builtin_amdgcn_s_barrier(); asm volatile("" ::: "memory");
#undef ATT_KROW
#undef ATT_DMA_K
#undef ATT_DMA_V
#undef ATT_VF
#undef ATT_PACK4
#undef ATT_EXP4
#undef ATT_STEP
#undef ATT_DRAIN
#undef ATT_ITER
}
#undef ATT_SB
}
__device__ __forceinline__ void phase_attn(const Frame& F, int l) {
    const float* qg = (const float*)F.in(I_Q_HEAD_G) + l * QKH;
    float sh; { const float* kgp = (const float*)F.in(I_K_HEAD_G) + l * QKH; float gm = 0.f, km = 0.f;
        for (int i = F.lane; i < QKH; i += 64) { gm = fmaxf(gm, fabsf(qg[i])); km = fmaxf(km, fabsf(kgp[i])); }
#pragma unroll
        for (int o = 1; o < 64; o <<= 1) { gm = fmaxf(gm, shfl_xor_(gm, o, F.lane)); km = fmaxf(km, shfl_xor_(km, o, F.lane)); }
        const float B = gm * km * 14.135f; sh = __builtin_bit_cast(float, __builtin_amdgcn_readfirstlane(__builtin_bit_cast(int, B > 90.f ? B - 64.f : 0.f))); }
    const bool fast = F.G == 256; const int v = F.vcu, c = v & 3; const int nu = fast ? (v < NH ? 5 : 4) : (NB * NH * 16 + NH - v + F.G - 1) / F.G;
    for (int i = 0; i < nu; ++i) {
        int bb, h, qb;
        if (fast) { if (i < 4) { const int bh = v >> 2; bb = bh >> 3; h = bh & 7; qb = i == 0 ? 15 - c : (i == 1 ? 8 + c : (i == 2 ? 7 - c : c)); } else { bb = -1; h = v; qb = 0; } }
        else { const int u = v + i * F.G; if (u < NB * NH * 16) { bb = u >> 7; h = (u >> 4) & 7; qb = u & 15; } else { bb = -1; h = u - NB * NH * 16; qb = 0; } }
        att::attn_unit(F, bb, h, qb, qg, sh);
    }
}

template <int MODE> __device__ __forceinline__ void mini_phase(const Frame& F, const bf16_t* A, int lda, const bf16_t* Bt, int ldb, int K, int ntasks, bf16_t* O, const float* SSQin, float* SSQout,
                                                           bf16_t* O2 = nullptr, const float* kgain = nullptr, const bf16_t* CQp = nullptr, const float* ropep = nullptr) {
    const int lane = F.lane, v = F.wave, fr = lane & 15, fq = lane >> 4, tile = v & 3, hv = v >> 2;
    LAS f32x4* part = (LAS f32x4*)F.lds; LAS float* sq = (LAS float*)(F.lds + 8192);
    for (int task = MODE == 2 ? (int)blockIdx.x : F.G - 1 - (int)blockIdx.x; task < ntasks; task += F.G) {
        int brow, kbeg, kend, acol = 0;
        if (MODE == 0) { brow = task < 8 ? 256 * (task >> 2) + 128 * (tile >> 1) + 32 * (task & 3) + 16 * (tile & 1) : 512 + 64 * (task - 8) + 16 * tile; kbeg = hv * (K / 2); kend = kbeg + K / 2; }
        else if (MODE == 2) { brow = 64 * task + 16 * tile; kbeg = hv * (K / 2); kend = kbeg + K / 2; }
        else if (MODE == 3) { const int hid = 64 * task + 16 * tile; brow = 256 * (hid >> 7) + (hid & 127) + 128 * hv; kbeg = 0; kend = K; }
        else { const int ch = 64 * task + 16 * tile, j = ch >> 7; brow = 256 * j + (ch & 127) + 128 * hv; acol = 256 * (j >> 1); kbeg = 0; kend = K; }
        const bf16_t* ap = A + (size_t)(MR + fr) * lda + acol + 8 * fq; const bf16_t* bp = Bt + (size_t)(brow + fr) * ldb + 8 * fq;
        f32x4 acc = {0.f, 0.f, 0.f, 0.f};
        for (int k = kbeg; k < kend; k += 512) {
            bf16x8 a16[16], b16[16];
#pragma unroll
            for (int i = 0; i < 16; ++i) if (k + 32 * i < kend) { a16[i] = *(const GAS bf16x8*)(ap + k + 32 * i); b16[i] = *(const GAS bf16x8*)(bp + k + 32 * i); }
#pragma unroll
            for (int i = 0; i < 16; ++i) if (k + 32 * i < kend) acc = __builtin_amdgcn_mfma_f32_16x16x32_bf16(b16[i], a16[i], acc, 0, 0, 0);
        }
        part[v * 64 + lane] = acc;
        __syncthreads();
        const int row = MR + fr; f32x4 xk = {0.f, 0.f, 0.f, 0.f};
        if (v < 4) {
            const f32x4 x = (MODE == 0 || MODE == 2) ? part[v * 64 + lane] + part[(v + 4) * 64 + lane] : part[v * 64 + lane]; const f32x4 y = part[(v + 4) * 64 + lane];
            const int col = 64 * task + 16 * tile + 4 * fq;
            if (MODE == 0) { const f32x4 t = *(const GAS f32x4*)(SSQin + (size_t)row * 16 + 8); const float rs = __builtin_amdgcn_rsqf(((t.x + t.y) + (t.z + t.w)) * (1.f / KVL) + EPS);
                xk = x * rs;
                if (task < 8) { float ss = sq4(xk); ss += shfl_xor_(ss, 16, lane); ss += shfl_xor_(ss, 32, lane); if (fq == 0) sq[tile * 16 + fr] = ss; }
                else { const int dv = 16 * tile + 4 * fq; *(GAS u32x2*)((unsigned char*)O2 + ((size_t)(row >> 6) * 8 + (task - 8)) * 8192 + ((dv >> 5) * 4 + ((row & 63) >> 4)) * 1024 + ((row & 15) * 4 + ((dv & 31) >> 3)) * 16 + (dv & 7) * 2) = (u32x2){pg8::cvt_pk_bf16(xk[0], xk[1]), pg8::cvt_pk_bf16(xk[2], xk[3])}; } }
            else if (MODE == 1) { *(GAS u32x4*)((unsigned*)O + (size_t)row * 512 + col) = (u32x4){pg8::cvt_pk_bf16(x[0], y[0]), pg8::cvt_pk_bf16(x[1], y[1]), pg8::cvt_pk_bf16(x[2], y[2]), pg8::cvt_pk_bf16(x[3], y[3])}; }
            else if (MODE == 2) { bf16_t* hp = O + (size_t)row * DM + col; const u32x2 w = *(const GAS u32x2*)hp; const f32x4 nv = (f32x4){bflo(w.x), bfhi(w.x), bflo(w.y), bfhi(w.y)} + x;
                *(GAS u32x2*)hp = (u32x2){pg8::cvt_pk_bf16(nv[0], nv[1]), pg8::cvt_pk_bf16(nv[2], nv[3])};
                if (O2) *(GAS unsigned*)((unsigned char*)O2 + (size_t)row * DM + col) = pk4_fp8(nv[0], nv[1], nv[2], nv[3]);
                float ss = sq4(nv); ss += shfl_xor_(ss, 16, lane); ss += shfl_xor_(ss, 32, lane); if (fq == 0) sq[tile * 16 + fr] = ss; }
            else { const float rs = __builtin_amdgcn_rsqf(ssq16(SSQin + (size_t)row * 16) * (1.f / DM) + EPS); f32x4 o;
#pragma unroll
                for (int i = 0; i < 4; ++i) o[i] = siluf_(x[i] * rs) * (y[i] * rs);
                *(GAS u32x2*)(O + (size_t)row * DFF + col) = (u32x2){pg8::cvt_pk_bf16(o[0], o[1]), pg8::cvt_pk_bf16(o[2], o[3])}; }
        }
        __syncthreads();
        if (MODE == 2 && v == 0 && lane < 16) SSQout[(size_t)(MR + lane) * 16 + task] = (sq[lane] + sq[16 + lane]) + (sq[32 + lane] + sq[48 + lane]);
        if (MODE == 0 && task < 8 && v < 4) {
            const float rk = __builtin_amdgcn_rsqf(((sq[fr] + sq[16 + fr]) + (sq[32 + fr] + sq[48 + fr]) + SSQin[(size_t)row * 16 + 12]) * (1.f / QKH) + EPS);
            unsigned char* kt = (unsigned char*)O + ((size_t)(row >> 6) * 8 + task) * 12288 + (row & 63) * 16; const int d0 = 16 * tile + 4 * fq; const f32x4 g = *(const GAS f32x4*)(kgain + d0); const f32x4 o = xk * g * rk;
            *(GAS u32x2*)(kt + (d0 >> 3) * 1024 + (fq & 1) * 8) = (u32x2){pg8::cvt_pk_bf16(o[0], o[1]), pg8::cvt_pk_bf16(o[2], o[3])};
            if (v == 0) { const f32x4 gr1 = *(const GAS f32x4*)(kgain + 64 + 4 * fq), gr2 = *(const GAS f32x4*)(kgain + 80 + 4 * fq);
                const u32x2 k1 = *(const GAS u32x2*)(CQp + (size_t)row * 512 + 384 + 4 * fq), k2 = *(const GAS u32x2*)(CQp + (size_t)row * 512 + 400 + 4 * fq);
                const f32x4 cc = *(const GAS f32x4*)(ropep + (size_t)row * 32 + 4 * fq), sn = *(const GAS f32x4*)(ropep + (size_t)row * 32 + 16 + 4 * fq);
                const f32x4 y1 = (f32x4){bflo(k1.x), bfhi(k1.x), bflo(k1.y), bfhi(k1.y)} * gr1 * rk, y2 = (f32x4){bflo(k2.x), bfhi(k2.x), bflo(k2.y), bfhi(k2.y)} * gr2 * rk;
                const f32x4 o1 = y1 * cc - y2 * sn, o2 = y2 * cc + y1 * sn;
                unsigned char* kr = kt + (8 + (fq >> 1)) * 1024 + (fq & 1) * 8;
                *(GAS u32x2*)kr = (u32x2){pg8::cvt_pk_bf16(o1[0], o1[1]), pg8::cvt_pk_bf16(o1[2], o1[3])}; *(GAS u32x2*)(kr + 2048) = (u32x2){pg8::cvt_pk_bf16(o2[0], o2[1]), pg8::cvt_pk_bf16(o2[2], o2[3])}; } }
    }
    __syncthreads();
}

struct PlainOrder : pg8::StaticOrder { static constexpr bool THIN_META = false; };
struct ColOrder : pg8::StaticOrder {
    static constexpr bool THIN_META = false;
    unsigned astride;
    __device__ bool next(int i, pg8::Unit& u) const { const bool ok = pg8::StaticOrder::next(i, u); if (ok) u.aoff = (unsigned)(u.pn >> 1) * astride; return ok; }
};
#define GRID_BAR() xcd_barrier(bar, wave_s)
#define FRAME() const Frame F = mkframe(lds_raw, wave_s); unsigned char* const ws = F.ws; unsigned char* const wb = ws + WS_W; unsigned char* const lw = wb + (size_t)l * W_LAYER; const int G = F.G, cid = (int)blockIdx.x; (void)wb; (void)lw; (void)G; (void)cid
template <int l> __device__ __forceinline__ void layer_phases(unsigned char* lds_raw, const XcdBarrier& bar, const int wave_s) {
    { FRAME();
      pg8::Gemm g{(const bf16_t*)(ws + WS_HB), (const bf16_t*)(lw + W_IN), DM, DM, DM}; pg8::StaticOrder S; S.init(NPANEL, NPROJ / 256, G, cid);
      EpiProj E{ws, (const float*)(ws + WS_SSQ1), (float*)(ws + WS_SSQC)}; pg8::gemm_phase<EpiProj, pg8::StaticOrder>(F.lds, g, S, E, F.tid); }
    if constexpr (l == 2) { FRAME(); constexpr int NIDLE = 256 - (NPANEL * (NPROJ / 256)) % 256;
      if (G == 256 && cid >= 256 - NIDLE) conv_moe_weights(F, 1, 0, JIT_SPLIT, cid - (256 - NIDLE), NIDLE, false); }
    GRID_BAR();
    { FRAME(); phase_e1(F, l); if (l & 1) phase_moe_init(F); if (l == 2) conv_moe_weights(F, 1, F.G == 256 ? JIT_SPLIT : 0); }
    GRID_BAR();
    { FRAME(); pg8::Gemm g{(const bf16_t*)(ws + T_CQ), (const bf16_t*)(lw + W_UQ), 512, QL, QL}; pg8::StaticOrder S; S.init(NPANEL, 768 / 256, G, cid);
      EpiUp E{(bf16_t*)((unsigned char*)F.out + D_Q), 768, (const float*)(ws + WS_SSQC), 0, 8, 1.f / QL}; pg8::gemm_phase<EpiUp, pg8::StaticOrder>(F.lds, g, S, E, F.tid); }
    { FRAME(); pg8::Gemm g{(const bf16_t*)(ws + T_CKV), (const bf16_t*)(lw + W_UKV), 256, KVL, KVL}; PlainOrder S; S.init(NPANEL - 1, 1024 / 256, G, cid);
      const float* kg = (const float*)F.in(I_K_HEAD_G) + l * QKH;
      EpiKV E{(bf16_t*)(ws + T_K), (bf16_t*)(ws + T_V), (const float*)(ws + WS_SSQC), (const bf16_t*)(ws + T_CQ), (const float*)(ws + WS_ROPE), kg}; pg8::gemm_phase<EpiKV, PlainOrder>(F.lds, g, S, E, F.tid); }
      { FRAME(); const float* kg = (const float*)F.in(I_K_HEAD_G) + l * QKH; mini_phase<0>(F, (const bf16_t*)(ws + T_CKV), 256, (const bf16_t*)(lw + W_UKV), KVL, KVL, 16, (bf16_t*)(ws + T_K), (const float*)(ws + WS_SSQC), nullptr, (bf16_t*)(ws + T_V), kg, (const bf16_t*)(ws + T_CQ), (const float*)(ws + WS_ROPE)); }
    { FRAME(); pg8::Gemm g{(const bf16_t*)(ws + T_XC), (const bf16_t*)(lw + W_G), 512, 256, 256}; ColOrder S; S.init(NPANEL - 1, 4, G, cid); S.astride = 512;
      EpiGates E{(unsigned*)((unsigned char*)F.out + D_AB)}; pg8::gemm_phase<EpiGates, ColOrder>(F.lds, g, S, E, F.tid); }
      { FRAME(); mini_phase<1>(F, (const bf16_t*)(ws + T_XC), 512, (const bf16_t*)(lw + W_G), 256, 256, 8, (bf16_t*)((unsigned char*)F.out + D_AB), nullptr, nullptr); }
    GRID_BAR();
    { FRAME(); phase_scan1(F, l); } { FRAME(); phase_attn(F, l); }
    GRID_BAR();
    { FRAME(); phase_scan3_mix(F, l); }
    GRID_BAR();
    { FRAME();
      pg8::Gemm g{(const bf16_t*)(ws + WS_BUFA), (const bf16_t*)(lw + W_OUT), DM, DM, DM}; PlainOrder S; S.init(NPANEL - 1, DM / 256, G, cid);
      EpiRes E{F.hb, (float*)(ws + WS_SSQ2), ws + WS_HB8, 1.f}; pg8::gemm_phase<EpiRes, PlainOrder>(F.lds, g, S, E, F.tid); }
      { FRAME(); mini_phase<2>(F, (const bf16_t*)(ws + WS_BUFA), DM, (const bf16_t*)(lw + W_OUT), DM, DM, 16, F.hb, nullptr, (float*)(ws + WS_SSQ2), (bf16_t*)(ws + WS_HB8)); }
    GRID_BAR();
    if constexpr (!(l & 1)) {
        constexpr int j = l >> 1;
        { FRAME(); unsigned char* dw = wb + W_DENSE + (size_t)j * W_DENSE_STRIDE;
          pg8::Gemm g{(const bf16_t*)(ws + WS_HB8), (const bf16_t*)(ws + WS_W8 + (size_t)j * SZ_W8), DM / 2, DM / 2, DM / 2}; PlainOrder S; S.init(NPANEL - 1, 2 * DFF / 256, G, cid);
          EpiSwiGLU E{(bf16_t*)(ws + T_ACT), DFF, (const float*)(ws + WS_SSQ2), 1.f / 64.f, ws + T_ACT}; pg8::gemm_phase<EpiSwiGLU, PlainOrder, false, true>(F.lds, g, S, E, F.tid); }
          { FRAME(); unsigned char* dw = wb + W_DENSE + (size_t)j * W_DENSE_STRIDE; mini_phase<3>(F, (const bf16_t*)(ws + WS_HB), DM, (const bf16_t*)dw, DM, DM, DFF / 64, (bf16_t*)(ws + T_ACT), (const float*)(ws + WS_SSQ2), nullptr); }
        GRID_BAR();
        { FRAME(); unsigned char* dw = wb + W_DENSE + (size_t)j * W_DENSE_STRIDE;
          pg8::Gemm g{(const bf16_t*)(ws + T_ACT), (const bf16_t*)(wb + W_MOE + NE * SZ_MUP8 + (size_t)j * SZ_DN8), DFF / 2, DFF / 2, DFF / 2}; PlainOrder S; S.init(NPANEL - 1, DM / 256, G, cid);
          EpiRes E{F.hb, (float*)(ws + WS_SSQ1), nullptr, 1.f / 64.f}; pg8::gemm_phase<EpiRes, PlainOrder, false, true>(F.lds, g, S, E, F.tid); }
          { FRAME(); unsigned char* dw = wb + W_DENSE + (size_t)j * W_DENSE_STRIDE; mini_phase<2>(F, (const bf16_t*)(ws + T_ACT), DFF, (const bf16_t*)(dw + SZ_UP), DFF, DFF, 16, F.hb, nullptr, (float*)(ws + WS_SSQ1)); }
        GRID_BAR();
    } else {
        constexpr int j = l >> 1;
        { FRAME(); phase_route(F, j); }
        GRID_BAR();
        { FRAME(); const LAS int* pfx = (const LAS int*)(F.lds + LDSCTL_OFF);
          moe_prefix(F);
          pg8::Gemm g{(const bf16_t*)(ws + WS_HB8), (const bf16_t*)(wb + W_MOE), DM / 2, DM / 2, DM / 2};
          MoeOrder S{2 * DFE / 256, G, cid, 0, pfx[16], pfx, (const int*)(ws + WS_LIST), (const f32x2*)(ws + WS_WLIST), (unsigned)SZ_MUP8};
          EpiSwiGLUMoe E{(bf16_t*)(ws + T_ACT)}; pg8::gemm_phase<EpiSwiGLUMoe, MoeOrder, true, true>(F.lds, g, S, E, F.tid); }
        GRID_BAR();
        { FRAME(); const LAS int* pfx = (const LAS int*)(F.lds + LDSCTL_OFF);
          moe_prefix(F);
          pg8::Gemm g{(const bf16_t*)(ws + T_ACT), (const bf16_t*)(wb + W_MOE_DN), DFE8 / 2, DFE8 / 2, DFE8 / 2};
          MoeOrder S{DM / 256, G, cid, 0, pfx[8], pfx, (const int*)(ws + WS_LIST), (const f32x2*)(ws + WS_WLIST), (unsigned)SZ_MDN8};
          EpiMoeDown E{F.hb, (float*)(ws + WS_SSQ1), F.out, 0}; pg8::gemm_phase<EpiMoeDown, MoeOrder, false, true>(F.lds, g, S, E, F.tid); }
        GRID_BAR();
        { FRAME(); const LAS int* pfx = (const LAS int*)(F.lds + LDSCTL_OFF);
          moe_prefix(F);
          pg8::Gemm g{(const bf16_t*)(ws + T_ACT), (const bf16_t*)(wb + W_MOE_DN), DFE8 / 2, DFE8 / 2, DFE8 / 2};
          MoeOrder S{DM / 256, G, cid, pfx[8], pfx[16], pfx, (const int*)(ws + WS_LIST), (const f32x2*)(ws + WS_WLIST), (unsigned)SZ_MDN8};
          EpiMoeDown E{F.hb, (float*)(ws + WS_SSQ1), F.out, l == DEPTH - 1 ? 2 : 1}; pg8::gemm_phase<EpiMoeDown, MoeOrder, false, true>(F.lds, g, S, E, F.tid); }
        if (l != DEPTH - 1) GRID_BAR();
    }
}
__global__ void __launch_bounds__(NTHREADS, 2) trunk_fwd(Args args) {
    extern __shared__ __attribute__((aligned(16))) unsigned char lds_raw[];
    const int wave_s = __builtin_amdgcn_readfirstlane((int)threadIdx.x >> 6);
    {
        LAS unsigned char* l3 = (LAS unsigned char*)lds_raw; const int t0 = wave_s * 64 + (int)__builtin_amdgcn_mbcnt_hi(~0u, __builtin_amdgcn_mbcnt_lo(~0u, 0u));
        for (int u = t0; u < (LDS_BYTES - LDSCTL_OFF) / 4; u += NTHREADS) ((LAS unsigned*)(l3 + LDSCTL_OFF))[u] = 0u;
        __syncthreads();
    }
    XcdBarrier bar = xcd_barrier_post((unsigned*)(args.ws + WS_CTL) + CW_BAR, (volatile LAS unsigned*)((LAS unsigned char*)lds_raw + MISC_OFF) + 8, wave_s);
    { const int l = 0; FRAME(); conv_mixer_dense_weights(F); conv_moe_weights(F, 0); prologue_misc(F); phase_x_to_hb(F); }
    GRID_BAR();
    layer_phases<0>(lds_raw, bar, wave_s);
    layer_phases<1>(lds_raw, bar, wave_s);
    layer_phases<2>(lds_raw, bar, wave_s);
    layer_phases<3>(lds_raw, bar, wave_s);
}
#undef GRID_BAR
#undef FRAME

extern "C" void kernel_launch(void* const* d_in, const int* in_sizes, int n_in, void* d_out, int out_size, void* d_ws, size_t ws_size, hipStream_t stream) {
    static int grid = 0;
    if (grid == 0) {
        if (n_in != 29 || out_size != MR * DM || ws_size < WS_END) { fprintf(stderr, "kernel_launch: unexpected shapes (n_in %d out %d ws %zu)\n", n_in, out_size, ws_size); grid = -1; return; }
        int dev = 0, cus = 0, per_cu = 0;
        if (hipGetDevice(&dev) != hipSuccess || hipDeviceGetAttribute(&cus, hipDeviceAttributeMultiprocessorCount, dev) != hipSuccess) { grid = -1; return; }
        if (hipFuncSetAttribute((const void*)trunk_fwd, hipFuncAttributeMaxDynamicSharedMemorySize, LDS_BYTES) != hipSuccess) { fprintf(stderr, "kernel_launch: hipFuncSetAttribute failed\n"); grid = -1; return; }
        if (hipOccupancyMaxActiveBlocksPerMultiprocessor(&per_cu, (const void*)trunk_fwd, NTHREADS, LDS_BYTES) != hipSuccess || per_cu < 1) { fprintf(stderr, "kernel_launch: occupancy query says %d\n", per_cu); }
        (void)hipGetLastError();
        grid = cus;
    }
    if (grid < 0) return;
    (void)hipMemsetAsync((char*)d_ws + WS_CTL, 0, CTL_ZERO_BYTES, stream);
    Args a{};
    for (int i = 0; i < 29; ++i) a.in[i] = d_in[i];
    a.out = (float*)d_out; a.ws = (unsigned char*)d_ws;
    hipLaunchKernelGGL(trunk_fwd, dim3(grid), dim3(NTHREADS), LDS_BYTES, stream, a);
}
```
